# Optimizing an MI355X kernel written in HIP

```python
import math
import jax, jax.numpy as jnp
from jax import lax
import numpy as np

D_MODEL = 1024
BATCH = 8
SEQ = 2048
DEPTH = 4

MEM_LEN = 256
RNN_WIDTH = D_MODEL
RNN_BLOCKS = 4
RNN_BLOCK = RNN_WIDTH // RNN_BLOCKS
CONV_WIDTH = 4
LRU_C = 8.0
HEAD_DIM = 64
N_Q_HEADS = D_MODEL // HEAD_DIM
N_KV_HEADS = 2
GROUP = N_Q_HEADS // N_KV_HEADS
ATTN_WIDTH = N_Q_HEADS * HEAD_DIM
KV_WIDTH = N_KV_HEADS * HEAD_DIM
WINDOW = 128
BLOCK = 128
ROPE_THETA = 500000.0
ROT_DIM = HEAD_DIM // 4
IN_COLS = 2 * RNN_WIDTH + ATTN_WIDTH + 2 * KV_WIDTH + 2 * D_MODEL
CROSS_HEADS = 4
CROSS_HEAD_DIM = D_MODEL // CROSS_HEADS
CROSS_WIDTH = CROSS_HEADS * CROSS_HEAD_DIM
D_FF = -(-8 * D_MODEL // (3 * 256)) * 256
LN_EPS = 1e-5
DEEPNORM_ALPHA = (2 * DEPTH) ** 0.25
DEEPNORM_BETA = (8 * DEPTH) ** -0.25
NEG_INF = -1e30

kernel_name = "hawk_swa_sink_hybrid_deepnorm_trunk"


def layer_norm(x, g, b):
    xf = x.astype(jnp.float32)
    mu = jnp.mean(xf, axis=-1, keepdims=True)
    var = jnp.mean(jnp.square(xf - mu), axis=-1, keepdims=True)
    y = (xf - mu) * lax.rsqrt(var + LN_EPS)
    return (y * g.astype(jnp.float32) + b.astype(jnp.float32)).astype(x.dtype)


def rope_tables(seq_len):
    pos = jnp.arange(seq_len, dtype=jnp.float32)
    inv_freq = ROPE_THETA ** (-jnp.arange(0, ROT_DIM, 2, dtype=jnp.float32) / ROT_DIM)
    ang = pos[:, None] * inv_freq[None, :]
    return jnp.cos(ang), jnp.sin(ang)


def apply_partial_rope(t, cos, sin):
    half = ROT_DIM // 2
    c = cos[None, :, None, :].astype(t.dtype)
    s = sin[None, :, None, :].astype(t.dtype)
    t1, t2, rest = t[..., :half], t[..., half:ROT_DIM], t[..., ROT_DIM:]
    return jnp.concatenate([t1 * c - t2 * s, t2 * c + t1 * s, rest], axis=-1)


def rglru_branch(xr, gr, conv_w, conv_b, w_rg, b_rg, w_ig, b_ig, lru_lambda):
    B, S, _ = xr.shape
    xp = jnp.pad(xr, ((0, 0), (CONV_WIDTH - 1, 0), (0, 0)))
    xc = conv_b
    for k in range(CONV_WIDTH):
        xc = xc + xp[:, k:k + S] * conv_w[k]
    xb = xc.reshape(B, S, RNN_BLOCKS, RNN_BLOCK)
    r = jax.nn.sigmoid(jnp.einsum('bsnc,ncd->bsnd', xb, w_rg).reshape(B, S, RNN_WIDTH) + b_rg)
    i = jax.nn.sigmoid(jnp.einsum('bsnc,ncd->bsnd', xb, w_ig).reshape(B, S, RNN_WIDTH) + b_ig)
    log_a = -LRU_C * r.astype(jnp.float32) * jax.nn.softplus(-lru_lambda.astype(jnp.float32))
    a = jnp.exp(log_a)
    mult = jnp.sqrt(-jnp.expm1(2.0 * log_a))
    b_in = mult * (i * xc).astype(jnp.float32)

    def combine(lhs, rhs):
        a1, b1 = lhs
        a2, b2 = rhs
        return a1 * a2, a2 * b1 + b2

    _, h = lax.associative_scan(combine, (a, b_in), axis=1)
    return h.astype(xr.dtype) * jax.nn.gelu(gr)


def swa_sink_branch(q, k, v, sinks, cos, sin):
    B, S, _ = q.shape
    NB = S // BLOCK
    q = apply_partial_rope(q.reshape(B, S, N_Q_HEADS, HEAD_DIM), cos, sin)
    k = apply_partial_rope(k.reshape(B, S, N_KV_HEADS, HEAD_DIM), cos, sin)
    v = v.reshape(B, S, N_KV_HEADS, HEAD_DIM)
    qb = q.reshape(B, NB, BLOCK, N_KV_HEADS, GROUP, HEAD_DIM)

    def band(t):
        tp = jnp.pad(t, ((0, 0), (BLOCK, 0), (0, 0), (0, 0))).reshape(B, NB + 1, BLOCK, N_KV_HEADS, HEAD_DIM)
        return jnp.concatenate([tp[:, :-1], tp[:, 1:]], axis=2)

    kb, vb = band(k), band(v)
    scores = jnp.einsum('bnqhgd,bnjhd->bnhgqj', qb, kb).astype(jnp.float32) * (HEAD_DIM ** -0.5)
    blk = jnp.arange(NB)[:, None, None]
    qpos = blk * BLOCK + jnp.arange(BLOCK)[None, :, None]
    kpos = (blk - 1) * BLOCK + jnp.arange(2 * BLOCK)[None, None, :]
    valid = (kpos <= qpos) & (kpos > qpos - WINDOW) & (kpos >= 0)
    scores = jnp.where(valid[None, :, None, None], scores, NEG_INF)
    sink = sinks.astype(jnp.float32).reshape(N_KV_HEADS, GROUP)[None, None, :, :, None, None]
    sink = jnp.broadcast_to(sink, scores.shape[:-1] + (1,))
    probs = jax.nn.softmax(jnp.concatenate([scores, sink], axis=-1), axis=-1)[..., :-1]
    out = jnp.einsum('bnhgqj,bnjhd->bnqhgd', probs.astype(vb.dtype), vb)
    return out.reshape(B, S, ATTN_WIDTH)


def hybrid_mixer(u, w_in, conv_w, conv_b, w_rg, b_rg, w_ig, b_ig, lru_lambda,
                 w_br_rnn, w_br_attn, sinks, w_out, cos, sin):
    widths = (RNN_WIDTH, RNN_WIDTH, ATTN_WIDTH, KV_WIDTH, KV_WIDTH, D_MODEL, D_MODEL)
    points = np.cumsum(widths)[:-1].tolist()
    proj = u @ w_in
    xr, gr, q, k, v, g_rnn, g_attn = jnp.split(proj, points, axis=-1)
    y_rnn = rglru_branch(xr, gr, conv_w, conv_b, w_rg, b_rg, w_ig, b_ig, lru_lambda)
    y_attn = swa_sink_branch(q, k, v, sinks, cos, sin)
    merged = jax.nn.sigmoid(g_rnn) * (y_rnn @ w_br_rnn) + jax.nn.sigmoid(g_attn) * (y_attn @ w_br_attn)
    return merged @ w_out


def cross_attention(u, mem, cq_w, ckv_w, co_w):
    B, S, _ = u.shape
    M = mem.shape[1]
    q = (u @ cq_w).reshape(B, S, CROSS_HEADS, CROSS_HEAD_DIM)
    k, v = jnp.split(mem @ ckv_w, 2, axis=-1)
    k = k.reshape(B, M, CROSS_HEADS, CROSS_HEAD_DIM)
    v = v.reshape(B, M, CROSS_HEADS, CROSS_HEAD_DIM)
    s = jnp.einsum('bshd,bmhd->bhsm', q, k).astype(jnp.float32) * (CROSS_HEAD_DIM ** -0.5)
    p = jax.nn.softmax(s, axis=-1)
    o = jnp.einsum('bhsm,bmhd->bshd', p.astype(v.dtype), v).reshape(B, S, CROSS_WIDTH)
    return o @ co_w


def swiglu(u, wi, wo):
    gate, up = jnp.split(u @ wi, 2, axis=-1)
    return (jax.nn.silu(gate) * up) @ wo


def setup_inputs(seed: int = 0) -> dict:
    key = jax.random.key(seed)
    ks = jax.random.split(key, 26)
    L = DEPTH
    f32 = jnp.float32

    def nrm(k, shape, scale):
        return jax.random.normal(k, shape, f32) * scale

    u = jax.random.uniform(ks[9], (L, RNN_WIDTH), f32, 0.9, 0.999)
    p = u ** (1.0 / LRU_C)
    lru_lambda = jnp.log(p) - jnp.log1p(-p)
    return {
        "x": nrm(ks[0], (BATCH, SEQ, D_MODEL), 1.0),
        "mem": nrm(ks[1], (BATCH, MEM_LEN, D_MODEL), 1.0),
        "w_in": nrm(ks[2], (L, D_MODEL, IN_COLS), D_MODEL ** -0.5),
        "conv_w": nrm(ks[3], (L, CONV_WIDTH, RNN_WIDTH), CONV_WIDTH ** -0.5),
        "conv_b": nrm(ks[4], (L, RNN_WIDTH), 0.01),
        "w_rg": nrm(ks[5], (L, RNN_BLOCKS, RNN_BLOCK, RNN_BLOCK), RNN_BLOCK ** -0.5),
        "b_rg": nrm(ks[6], (L, RNN_WIDTH), 0.01),
        "w_ig": nrm(ks[7], (L, RNN_BLOCKS, RNN_BLOCK, RNN_BLOCK), RNN_BLOCK ** -0.5),
        "b_ig": nrm(ks[8], (L, RNN_WIDTH), 0.01),
        "lru_lambda": lru_lambda,
        "w_br_rnn": nrm(ks[10], (L, RNN_WIDTH, D_MODEL), RNN_WIDTH ** -0.5),
        "w_br_attn": nrm(ks[11], (L, ATTN_WIDTH, D_MODEL), ATTN_WIDTH ** -0.5),
        "sinks": nrm(ks[12], (L, N_Q_HEADS), 0.5),
        "w_out": nrm(ks[13], (L, D_MODEL, D_MODEL), DEEPNORM_BETA * D_MODEL ** -0.5),
        "ln1_g": 1.0 + nrm(ks[14], (L, D_MODEL), 0.02),
        "ln1_b": nrm(ks[15], (L, D_MODEL), 0.02),
        "cq_w": nrm(ks[16], (L, D_MODEL, CROSS_WIDTH), D_MODEL ** -0.5),
        "ckv_w": nrm(ks[17], (L, D_MODEL, 2 * CROSS_WIDTH), D_MODEL ** -0.5),
        "co_w": nrm(ks[18], (L, CROSS_WIDTH, D_MODEL), DEEPNORM_BETA * CROSS_WIDTH ** -0.5),
        "ln2_g": 1.0 + nrm(ks[19], (L, D_MODEL), 0.02),
        "ln2_b": nrm(ks[20], (L, D_MODEL), 0.02),
        "ffn_wi": nrm(ks[21], (L, D_MODEL, 2 * D_FF), D_MODEL ** -0.5),
        "ffn_wo": nrm(ks[22], (L, D_FF, D_MODEL), DEEPNORM_BETA * D_FF ** -0.5),
        "ln3_g": 1.0 + nrm(ks[23], (L, D_MODEL), 0.02),
        "ln3_b": nrm(ks[24], (L, D_MODEL), 0.02),
    }


def reference(x, mem, w_in, conv_w, conv_b, w_rg, b_rg, w_ig, b_ig, lru_lambda,
              w_br_rnn, w_br_attn, sinks, w_out, ln1_g, ln1_b,
              cq_w, ckv_w, co_w, ln2_g, ln2_b,
              ffn_wi, ffn_wo, ln3_g, ln3_b):
    cos, sin = rope_tables(x.shape[1])
    h = x
    for l in range(DEPTH):
        mix = hybrid_mixer(h, w_in[l], conv_w[l], conv_b[l], w_rg[l], b_rg[l], w_ig[l], b_ig[l],
                           lru_lambda[l], w_br_rnn[l], w_br_attn[l], sinks[l], w_out[l], cos, sin)
        h = layer_norm(DEEPNORM_ALPHA * h + mix, ln1_g[l], ln1_b[l])
        h = layer_norm(DEEPNORM_ALPHA * h + cross_attention(h, mem, cq_w[l], ckv_w[l], co_w[l]),
                       ln2_g[l], ln2_b[l])
        h = layer_norm(DEEPNORM_ALPHA * h + swiglu(h, ffn_wi[l], ffn_wo[l]), ln3_g[l], ln3_b[l])
    return h
```

```cpp
#include <hip/hip_runtime.h>
#include <hip/hip_cooperative_groups.h>
#include <cstdint>
#include <cstdio>
namespace cg = cooperative_groups;

#define LAS __attribute__((address_space(3)))
typedef _Float16 half_t;
typedef _Float16 h8 __attribute__((ext_vector_type(8)));
typedef _Float16 h4 __attribute__((ext_vector_type(4)));
typedef float f32x4 __attribute__((ext_vector_type(4)));
typedef float f32x2 __attribute__((ext_vector_type(2)));

constexpr int DM = 1024, BATCH = 8, SEQ = 2048, DEPTH = 4, M = BATCH * SEQ, MEMLEN = 256, MMEM = BATCH * MEMLEN;
constexpr int INC = 5376, DFF = 2816;
constexpr float ALPHA = 1.681792830507429f, LN_EPS = 1e-5f;
constexpr int NWAVES = 8, NTHREADS = 512;
constexpr int LDS_BYTES = 147456;

constexpr size_t MiB = 1u << 20;
constexpr size_t WS_ROPE = 1 * MiB;
constexpr size_t WS_W = 2 * MiB;
constexpr size_t W_IN = 0, W_G = 11010048, W_BR = W_G + 1 * MiB, W_BA = W_BR + 2 * MiB, W_OUT = W_BA + 2 * MiB, W_CQ = W_OUT + 2 * MiB,
                 W_CO = W_CQ + 2 * MiB, W_CKV = W_CO + 2 * MiB, W_FI = W_CKV + 4 * MiB, W_FO = W_FI + 11534336, W_END = W_FO + 5767168;
static_assert(W_END == 42 * MiB, "weights");
constexpr size_t WS_MEM16 = 86 * MiB, WS_KB = 90 * MiB, WS_VT = 94 * MiB, WS_KC = 98 * MiB, WS_VCT = 102 * MiB, WS_SLOT = 106 * MiB, SLOT = 32 * MiB;
constexpr size_t WS_END = WS_SLOT + 8 * SLOT;

struct Args {
    const float* in[25];
    float* out; unsigned char* ws;
    int ph_lo, ph_hi;
};
enum { I_X = 0, I_MEM, I_WIN, I_CONVW, I_CONVB, I_WRG, I_BRG, I_WIG, I_BIG, I_LAM, I_WBR, I_WBA, I_SINK, I_WOUT, I_LN1G, I_LN1B, I_CQ, I_CKV, I_CO, I_LN2G, I_LN2B,
       I_FWI, I_FWO, I_LN3G, I_LN3B };

__device__ __forceinline__ float wave_sum(float v) {
#pragma unroll
    for (int o = 1; o < 64; o <<= 1) v += __shfl_xor(v, o);
    return v;
}
__device__ __forceinline__ float wave_max(float v) {
#pragma unroll
    for (int o = 1; o < 64; o <<= 1) v = fmaxf(v, __shfl_xor(v, o));
    return v;
}
__device__ __forceinline__ float sigm(float x) { return 1.f / (1.f + __expf(-x)); }
__device__ __forceinline__ float gelu_tanh(float x) {
    const float u = 0.7978845608028654f * (x + 0.044715f * x * x * x);
    const float t = 1.f - 2.f / (__expf(2.f * u) + 1.f);
    return 0.5f * x * (1.f + t);
}
__device__ __forceinline__ h8 pack8(f32x4 a, f32x4 b) {
    h8 v; v[0] = (half_t)a[0]; v[1] = (half_t)a[1]; v[2] = (half_t)a[2]; v[3] = (half_t)a[3]; v[4] = (half_t)b[0]; v[5] = (half_t)b[1]; v[6] = (half_t)b[2]; v[7] = (half_t)b[3];
    return v;
}

struct Unit { int pm, pn, seg; };
struct GemmSeg { const half_t* A; const half_t* Bt; int lda, ldb; };
struct Gemm { GemmSeg s[4]; int K; };

template <class Epi, class Sched>
__device__ __forceinline__ void gemm_simple(const Gemm g, const Sched& S, const Epi& E, const int tid) {
    const int wid = __builtin_amdgcn_readfirstlane(tid >> 6), lane = tid & 63, wr = wid >> 2, wc = wid & 3, fr = lane & 15, fq = lane >> 4;
    f32x4 acc[2][2][4][2];
#pragma unroll
    for (int a = 0; a < 2; ++a)
#pragma unroll
        for (int b = 0; b < 2; ++b)
#pragma unroll
            for (int m = 0; m < 4; ++m)
#pragma unroll
                for (int n = 0; n < 2; ++n) acc[a][b][m][n] = (f32x4){0.f, 0.f, 0.f, 0.f};
    Unit u;
    for (int i = 0; S.next(i, u); ++i) {
        const half_t* A = u.seg == 0 ? g.s[0].A : u.seg == 1 ? g.s[1].A : u.seg == 2 ? g.s[2].A : g.s[3].A;
        const half_t* Bt = u.seg == 0 ? g.s[0].Bt : u.seg == 1 ? g.s[1].Bt : u.seg == 2 ? g.s[2].Bt : g.s[3].Bt;
        const int lda = u.seg == 0 ? g.s[0].lda : u.seg == 1 ? g.s[1].lda : u.seg == 2 ? g.s[2].lda : g.s[3].lda;
        const int ldb = u.seg == 0 ? g.s[0].ldb : u.seg == 1 ? g.s[1].ldb : u.seg == 2 ? g.s[2].ldb : g.s[3].ldb;
        const half_t* Ab = A + (size_t)(u.pm * 256 + wr * 64 + fr) * lda + fq * 8;
        const half_t* Bb = Bt + (size_t)(u.pn * 256 + wc * 32 + 8 * (fr >> 2) + (fr & 3)) * ldb + fq * 8;
        for (int kk = 0; kk < g.K; kk += 32) {
            h8 af[2][4], bf[2][2];
#pragma unroll
            for (int ai = 0; ai < 2; ++ai)
#pragma unroll
                for (int m = 0; m < 4; ++m) af[ai][m] = *(const h8*)(Ab + (size_t)(ai * 128 + m * 16) * lda + kk);
#pragma unroll
            for (int bj = 0; bj < 2; ++bj)
#pragma unroll
                for (int n = 0; n < 2; ++n) bf[bj][n] = *(const h8*)(Bb + (size_t)(bj * 128 + n * 4) * ldb + kk);
#pragma unroll
            for (int ai = 0; ai < 2; ++ai)
#pragma unroll
                for (int bj = 0; bj < 2; ++bj)
#pragma unroll
                    for (int m = 0; m < 4; ++m)
#pragma unroll
                        for (int n = 0; n < 2; ++n) acc[ai][bj][m][n] = __builtin_amdgcn_mfma_f32_16x16x32_f16(bf[bj][n], af[ai][m], acc[ai][bj][m][n], 0, 0, 0);
        }
        const bool keep = E(acc, u, wr, wc, fr, fq);
        if (!keep) {
#pragma unroll
            for (int a = 0; a < 2; ++a)
#pragma unroll
                for (int b = 0; b < 2; ++b)
#pragma unroll
                    for (int m = 0; m < 4; ++m)
#pragma unroll
                        for (int n = 0; n < 2; ++n) acc[a][b][m][n] = (f32x4){0.f, 0.f, 0.f, 0.f};
        }
    }
}

struct SchedIn {
    int G, c;
    __device__ __forceinline__ bool next(int i, Unit& u) const {
        const int L = i * G + c; if (L >= 1408) return false;
        if (L < 1344) { u.seg = 0; u.pm = L / 21; u.pn = L % 21; } else { const int r = L - 1344; u.seg = 1; u.pm = r >> 3; u.pn = r & 7; }
        return true;
    }
};
struct SchedGate {
    int G, c;
    __device__ __forceinline__ bool next(int i, Unit& u) const {
        const int L = i * G + c; if (L >= 512) return false;
        u.pn = L & 1; u.seg = (L >> 1) & 3; u.pm = L >> 3; return true;
    }
};
struct SchedBr {
    int G, c;
    __device__ __forceinline__ bool next(int i, Unit& u) const {
        const int t = (i >> 1) * G + c; if (t >= 256) return false;
        u.seg = i & 1; u.pm = t >> 2; u.pn = t & 3; return true;
    }
};
struct SchedMN {
    int G, c, nN, total;
    __device__ __forceinline__ bool next(int i, Unit& u) const {
        const int L = i * G + c; if (L >= total) return false;
        u.seg = 0; u.pm = L / nN; u.pn = L % nN; return true;
    }
};

#define EPI_ROWS for (int ai = 0; ai < 2; ++ai) _Pragma("unroll") for (int m = 0; m < 4; ++m)
struct EpiIn {
    half_t *XR, *GG, *Q, *KB, *VT, *GR, *GA, *KC, *VCT;
    __device__ __forceinline__ bool operator()(f32x4 (&acc)[2][2][4][2], const Unit& u, int wr, int wc, int fr, int fq) const {
        const int pn = u.pn;
#pragma unroll
        EPI_ROWS {
            const int row = u.pm * 256 + ai * 128 + wr * 64 + m * 16 + fr;
#pragma unroll
            for (int bj = 0; bj < 2; ++bj) {
                const int ct = bj * 128 + wc * 32 + fq * 8;
                f32x4 a = acc[ai][bj][m][0], b = acc[ai][bj][m][1];
                if (u.seg == 0) {
                    if (pn < 4) *(h8*)(XR + (size_t)row * 1024 + pn * 256 + ct) = pack8(a, b);
                    else if (pn < 8) {
#pragma unroll
                        for (int e = 0; e < 4; ++e) { a[e] = gelu_tanh(a[e]); b[e] = gelu_tanh(b[e]); }
                        *(h8*)(GG + (size_t)row * 1024 + (pn - 4) * 256 + ct) = pack8(a, b);
                    } else if (pn < 12) *(h8*)(Q + (size_t)row * 1024 + (pn - 8) * 256 + ct) = pack8(a, b);
                    else if (pn == 12) {
                        if (bj == 0) *(h8*)(KB + (size_t)row * 128 + ct) = pack8(a, b);
                        else {
                            const int d0 = ct - 128, kvh = d0 >> 6, dd = d0 & 63, bb = row >> 11, s = row & 2047;
                            half_t* p = VT + ((size_t)((bb * 2 + kvh) * 64 + dd)) * 2048 + s;
                            const h8 v = pack8(a, b);
#pragma unroll
                            for (int e = 0; e < 8; ++e) p[(size_t)e * 2048] = v[e];
                        }
                    } else if (pn < 17) *(h8*)(GR + (size_t)row * 1024 + (pn - 13) * 256 + ct) = pack8(a, b);
                    else *(h8*)(GA + (size_t)row * 1024 + (pn - 17) * 256 + ct) = pack8(a, b);
                } else {
                    if (pn < 4) *(h8*)(KC + (size_t)row * 1024 + pn * 256 + ct) = pack8(a, b);
                    else {
                        const int hh = pn - 4, bb = row >> 8, mm = row & 255;
                        half_t* p = VCT + ((size_t)((bb * 4 + hh) * 256 + ct)) * 256 + mm;
                        const h8 v = pack8(a, b);
#pragma unroll
                        for (int e = 0; e < 8; ++e) p[(size_t)e * 256] = v[e];
                    }
                }
            }
        }
        return false;
    }
};
struct EpiGate {
    const half_t* XC; const float *brg, *big, *lam; half_t *LA, *BI;
    __device__ __forceinline__ bool operator()(f32x4 (&acc)[2][2][4][2], const Unit& u, int wr, int wc, int fr, int fq) const {
        const int ch0 = u.seg * 256 + u.pn * 128 + wc * 32 + fq * 8;
        float sp[8], b1[8], b2[8];
#pragma unroll
        for (int e = 0; e < 8; ++e) { sp[e] = log1pf(__expf(-lam[ch0 + e])); b1[e] = brg[ch0 + e]; b2[e] = big[ch0 + e]; }
#pragma unroll
        EPI_ROWS {
            const int row = u.pm * 256 + ai * 128 + wr * 64 + m * 16 + fr;
            const h8 xc = *(const h8*)(XC + (size_t)row * 1024 + ch0);
            h8 la, bi;
#pragma unroll
            for (int e = 0; e < 8; ++e) {
                const float r = sigm(acc[ai][0][m][e >> 2][e & 3] + b1[e]), ig = sigm(acc[ai][1][m][e >> 2][e & 3] + b2[e]);
                const float l = -8.f * r * sp[e];
                const float mult = sqrtf(-expm1f(2.f * l));
                la[e] = (half_t)l; bi[e] = (half_t)(mult * ig * (float)xc[e]);
            }
            *(h8*)(LA + (size_t)row * 1024 + ch0) = la; *(h8*)(BI + (size_t)row * 1024 + ch0) = bi;
        }
        return false;
    }
};
struct EpiBr {
    const half_t *GR, *GA; half_t* MG;
    __device__ __forceinline__ bool operator()(f32x4 (&acc)[2][2][4][2], const Unit& u, int wr, int wc, int fr, int fq) const {
#pragma unroll
        EPI_ROWS {
            const int row = u.pm * 256 + ai * 128 + wr * 64 + m * 16 + fr;
#pragma unroll
            for (int bj = 0; bj < 2; ++bj) {
                const size_t off = (size_t)row * 1024 + u.pn * 256 + bj * 128 + wc * 32 + fq * 8;
                const h8 ga = *(const h8*)(GA + off);
                if (u.seg == 0) {
                    const h8 gr = *(const h8*)(GR + off);
#pragma unroll
                    for (int e = 0; e < 8; ++e) acc[ai][bj][m][e >> 2][e & 3] *= (1.f + __expf(-(float)ga[e])) / (1.f + __expf(-(float)gr[e]));
                } else {
                    h8 o;
#pragma unroll
                    for (int e = 0; e < 8; ++e) o[e] = (half_t)(acc[ai][bj][m][e >> 2][e & 3] / (1.f + __expf(-(float)ga[e])));
                    *(h8*)(MG + off) = o;
                }
            }
        }
        return u.seg == 0;
    }
};
struct EpiRes {
    const float* base; float* out;
    __device__ __forceinline__ bool operator()(f32x4 (&acc)[2][2][4][2], const Unit& u, int wr, int wc, int fr, int fq) const {
#pragma unroll
        EPI_ROWS {
            const int row = u.pm * 256 + ai * 128 + wr * 64 + m * 16 + fr;
#pragma unroll
            for (int bj = 0; bj < 2; ++bj) {
                const size_t off = (size_t)row * 1024 + u.pn * 256 + bj * 128 + wc * 32 + fq * 8;
                const f32x4 x0 = *(const f32x4*)(base + off), x1 = *(const f32x4*)(base + off + 4);
                *(f32x4*)(out + off) = x0 * ALPHA + acc[ai][bj][m][0]; *(f32x4*)(out + off + 4) = x1 * ALPHA + acc[ai][bj][m][1];
            }
        }
        return false;
    }
};
struct EpiScale {
    half_t* O; float sc;
    __device__ __forceinline__ bool operator()(f32x4 (&acc)[2][2][4][2], const Unit& u, int wr, int wc, int fr, int fq) const {
#pragma unroll
        EPI_ROWS {
            const int row = u.pm * 256 + ai * 128 + wr * 64 + m * 16 + fr;
#pragma unroll
            for (int bj = 0; bj < 2; ++bj) {
                const size_t off = (size_t)row * 1024 + u.pn * 256 + bj * 128 + wc * 32 + fq * 8;
                *(h8*)(O + off) = pack8(acc[ai][bj][m][0] * sc, acc[ai][bj][m][1] * sc);
            }
        }
        return false;
    }
};
struct EpiSwiglu {
    half_t* HF;
    __device__ __forceinline__ bool operator()(f32x4 (&acc)[2][2][4][2], const Unit& u, int wr, int wc, int fr, int fq) const {
#pragma unroll
        EPI_ROWS {
            const int row = u.pm * 256 + ai * 128 + wr * 64 + m * 16 + fr;
            h8 o;
#pragma unroll
            for (int e = 0; e < 8; ++e) { const float gt = acc[ai][0][m][e >> 2][e & 3], up = acc[ai][1][m][e >> 2][e & 3]; o[e] = (half_t)(gt * sigm(gt) * up); }
            *(h8*)(HF + (size_t)row * DFF + u.pn * 128 + wc * 32 + fq * 8) = o;
        }
        return false;
    }
};

__device__ __forceinline__ int rowmap(int kind, int n0) {
    if (kind == 0) return n0;
    if (kind == 1) return (n0 >> 7) * 256 + (n0 & 127);
    if (kind == 2) return (n0 >> 7) * 256 + 128 + (n0 & 127);
    if (n0 < DFF) return (n0 >> 7) * 256 + (n0 & 127);
    const int j = n0 - DFF; return (j >> 7) * 256 + 128 + (j & 127);
}
__device__ __forceinline__ void conv_job(const float* W, int K, int N, half_t* WT, int kind, LAS float* scr, int gw, int NGW, int& base, int lane) {
    const int nblk = N / 32, nitems = (K / 64) * nblk;
    int first = gw - (base % NGW); if (first < 0) first += NGW;
    for (int item = first; item < nitems; item += NGW) {
        const int kb = item / nblk, nb = item % nblk, k0 = 64 * kb, n0 = 32 * nb;
#pragma unroll 8
        for (int i = 0; i < 32; ++i) { const int kk = 2 * i + (lane >> 5); scr[kk * 33 + (lane & 31)] = W[(size_t)(k0 + kk) * N + n0 + (lane & 31)]; }
        asm volatile("s_waitcnt lgkmcnt(0)" ::: "memory");
        const int c = lane & 7, r0 = rowmap(kind, n0);
#pragma unroll
        for (int j = 0; j < 4; ++j) {
            const int n = (lane >> 3) + 8 * j; const LAS float* s = scr + (8 * c) * 33 + n;
            h8 o;
#pragma unroll
            for (int e = 0; e < 8; ++e) o[e] = (half_t)s[e * 33];
            *(h8*)(WT + (size_t)(r0 + n) * K + k0 + 8 * c) = o;
        }
        asm volatile("s_waitcnt lgkmcnt(0)" ::: "memory");
    }
    base += nitems;
}

constexpr int NPH = 15;
__constant__ double INVF[8] = {1.0, 0.19392274474868576, 0.03760603093086393, 0.007292664737217109, 0.001414213562373095, 0.0002742481756762073, 5.318295896944988e-05, 1.031338537721246e-05};
__device__ __forceinline__ void sincos_d(double ang, float& c, float& s) {
    const double n = __builtin_rint(ang * 0.6366197723675814);
    double r = __builtin_fma(-n, 1.5707963267948966, ang); r = __builtin_fma(-n, 6.123233995736766e-17, r);
    const double r2 = r * r;
    double sp = r * (1.0 + r2 * (-1.0 / 6 + r2 * (1.0 / 120 + r2 * (-1.0 / 5040 + r2 * (1.0 / 362880 + r2 * (-1.0 / 39916800 + r2 * (1.0 / 6227020800.0)))))));
    double cp = 1.0 + r2 * (-0.5 + r2 * (1.0 / 24 + r2 * (-1.0 / 720 + r2 * (1.0 / 40320 + r2 * (-1.0 / 3628800 + r2 * (1.0 / 479001600 + r2 * (-1.0 / 87178291200.0)))))));
    const int q = ((int)n) & 3;
    const double cc = (q == 0) ? cp : (q == 1) ? -sp : (q == 2) ? -cp : sp;
    const double ss = (q == 0) ? sp : (q == 1) ? cp : (q == 2) ? -sp : -cp;
    c = (float)cc; s = (float)ss;
}

__device__ __forceinline__ void run_phase(const Args& args, const int ph, unsigned char* ws, const int tid, LAS unsigned char* lds) {
    const int lane = tid & 63, wid = __builtin_amdgcn_readfirstlane(tid >> 6);
    const int G = gridDim.x, c = blockIdx.x, gw = c * NWAVES + wid, NGW = G * NWAVES;
    f32x2* ROPE = (f32x2*)(ws + WS_ROPE);
    half_t *W_in = (half_t*)(ws + WS_W + W_IN), *W_g = (half_t*)(ws + WS_W + W_G), *W_br = (half_t*)(ws + WS_W + W_BR), *W_ba = (half_t*)(ws + WS_W + W_BA),
           *W_out = (half_t*)(ws + WS_W + W_OUT), *W_cq = (half_t*)(ws + WS_W + W_CQ), *W_co = (half_t*)(ws + WS_W + W_CO), *W_ckv = (half_t*)(ws + WS_W + W_CKV),
           *W_fi = (half_t*)(ws + WS_W + W_FI), *W_fo = (half_t*)(ws + WS_W + W_FO);
    half_t *MEM16 = (half_t*)(ws + WS_MEM16), *KB = (half_t*)(ws + WS_KB), *VT = (half_t*)(ws + WS_VT), *KC = (half_t*)(ws + WS_KC), *VCT = (half_t*)(ws + WS_VCT);
#define SLOTP(i) ((half_t*)(ws + WS_SLOT + (size_t)(i) * SLOT))
    half_t *H16 = SLOTP(0), *XR = SLOTP(1), *LA = SLOTP(1), *MG = SLOTP(1), *GG = SLOTP(2), *QC = SLOTP(2), *Q = SLOTP(3), *BI = SLOTP(3), *OC = SLOTP(3),
           *GR = SLOTP(4), *GA = SLOTP(5), *XC = SLOTP(6), *YR = SLOTP(6), *YA = SLOTP(7), *HF = SLOTP(4);
    float* OUT = args.out;
    {
        const int l = ph / NPH, k = ph % NPH;
        if (k == 0) {
            LAS float* scr = (LAS float*)(lds + wid * 16384);
            int base = 0;
            conv_job(args.in[I_WIN] + (size_t)l * DM * INC, DM, INC, W_in, 0, scr, gw, NGW, base, lane);
            conv_job(args.in[I_FWI] + (size_t)l * DM * 2 * DFF, DM, 2 * DFF, W_fi, 3, scr, gw, NGW, base, lane);
            conv_job(args.in[I_FWO] + (size_t)l * DFF * DM, DFF, DM, W_fo, 0, scr, gw, NGW, base, lane);
            conv_job(args.in[I_CKV] + (size_t)l * DM * 2048, DM, 2048, W_ckv, 0, scr, gw, NGW, base, lane);
            conv_job(args.in[I_WBR] + (size_t)l * DM * DM, DM, DM, W_br, 0, scr, gw, NGW, base, lane);
            conv_job(args.in[I_WBA] + (size_t)l * DM * DM, DM, DM, W_ba, 0, scr, gw, NGW, base, lane);
            conv_job(args.in[I_WOUT] + (size_t)l * DM * DM, DM, DM, W_out, 0, scr, gw, NGW, base, lane);
            conv_job(args.in[I_CQ] + (size_t)l * DM * DM, DM, DM, W_cq, 0, scr, gw, NGW, base, lane);
            conv_job(args.in[I_CO] + (size_t)l * DM * DM, DM, DM, W_co, 0, scr, gw, NGW, base, lane);
            for (int n = 0; n < 4; ++n) {
                conv_job(args.in[I_WRG] + (size_t)(l * 4 + n) * 65536, 256, 256, W_g + (size_t)n * 512 * 256, 1, scr, gw, NGW, base, lane);
                conv_job(args.in[I_WIG] + (size_t)(l * 4 + n) * 65536, 256, 256, W_g + (size_t)n * 512 * 256, 2, scr, gw, NGW, base, lane);
            }
            if (l == 0) {
                const int gt = c * NTHREADS + tid, NGT = G * NTHREADS;
                const float* x = args.in[I_X]; const float* mem = args.in[I_MEM];
                for (int i = gt; i < M * DM / 8; i += NGT) { const f32x4 a = *(const f32x4*)(x + (size_t)i * 8), b = *(const f32x4*)(x + (size_t)i * 8 + 4); *(h8*)(H16 + (size_t)i * 8) = pack8(a, b); }
                for (int i = gt; i < MMEM * DM / 8; i += NGT) { const f32x4 a = *(const f32x4*)(mem + (size_t)i * 8), b = *(const f32x4*)(mem + (size_t)i * 8 + 4); *(h8*)(MEM16 + (size_t)i * 8) = pack8(a, b); }
                for (int i = gt; i < SEQ * 8; i += NGT) {
                    const int pos = i >> 3, fi = i & 7;
                    const double invf = INVF[fi];
                    float cs, sn; sincos_d((double)pos * invf, cs, sn);
                    ROPE[i] = (f32x2){cs, sn};
                }
            }
        } else if (k == 1) {
            Gemm g; g.K = DM; g.s[0] = {H16, W_in, DM, DM}; g.s[1] = {MEM16, W_ckv, DM, DM}; g.s[2] = g.s[0]; g.s[3] = g.s[0];
            SchedIn S{G, c}; EpiIn E{XR, GG, Q, KB, VT, GR, GA, KC, VCT};
            gemm_simple(g, S, E, tid);
        } else if (k == 2) {
            {
                const float* cw = args.in[I_CONVW] + (size_t)l * 4 * DM; const float* cb = args.in[I_CONVB] + (size_t)l * DM;
                const int gt = c * NTHREADS + tid, NGT = G * NTHREADS;
                for (int i = gt; i < M * 128; i += NGT) {
                    const int row = i >> 7, ch = (i & 127) * 8, s = row & 2047;
                    float a[8];
#pragma unroll
                    for (int e = 0; e < 8; ++e) a[e] = cb[ch + e];
#pragma unroll
                    for (int kk = 0; kk < 4; ++kk) {
                        if (s - 3 + kk >= 0) {
                            const h8 v = *(const h8*)(XR + (size_t)(row - 3 + kk) * 1024 + ch);
#pragma unroll
                            for (int e = 0; e < 8; ++e) a[e] += (float)v[e] * cw[kk * DM + ch + e];
                        }
                    }
                    h8 o;
#pragma unroll
                    for (int e = 0; e < 8; ++e) o[e] = (half_t)a[e];
                    *(h8*)(XC + (size_t)row * 1024 + ch) = o;
                }
            }
            {
                const float* sinks = args.in[I_SINK] + l * 16;
                for (int it = gw; it < M * 16; it += NGW) {
                    const int row = it >> 4, hh = it & 15, bb = row >> 11, s = row & 2047, kvh = hh >> 3;
                    const half_t* qp = Q + (size_t)row * 1024 + hh * 64;
                    float q1[8], q2[8];
                    { const h8 a = *(const h8*)qp, b = *(const h8*)(qp + 8);
#pragma unroll
                      for (int e = 0; e < 8; ++e) { const f32x2 cs = ROPE[s * 8 + e]; const float t1 = (float)a[e], t2 = (float)b[e]; q1[e] = t1 * cs.x - t2 * cs.y; q2[e] = t2 * cs.x + t1 * cs.y; } }
                    float sc[2];
#pragma unroll
                    for (int jj = 0; jj < 2; ++jj) {
                        const int kpos = s - lane - 64 * jj;
                        float d = -1e30f;
                        if (kpos >= 0) {
                            const half_t* kp = KB + (size_t)(bb * 2048 + kpos) * 128 + kvh * 64;
                            const h8 a = *(const h8*)kp, b = *(const h8*)(kp + 8);
                            float acc = 0.f;
#pragma unroll
                            for (int e = 0; e < 8; ++e) { const f32x2 cs = ROPE[kpos * 8 + e]; const float t1 = (float)a[e], t2 = (float)b[e]; acc += q1[e] * (t1 * cs.x - t2 * cs.y) + q2[e] * (t2 * cs.x + t1 * cs.y); }
#pragma unroll
                            for (int d0 = 16; d0 < 64; d0 += 8) { const h8 qv = *(const h8*)(qp + d0), kv = *(const h8*)(kp + d0);
#pragma unroll
                                for (int e = 0; e < 8; ++e) acc += (float)qv[e] * (float)kv[e]; }
                            d = acc * 0.125f;
                        }
                        sc[jj] = d;
                    }
                    const float sk = sinks[hh];
                    const float mx = fmaxf(wave_max(fmaxf(sc[0], sc[1])), sk);
                    float p0 = __expf(sc[0] - mx), p1 = __expf(sc[1] - mx);
                    const float den = wave_sum(p0 + p1) + __expf(sk - mx);
                    p0 /= den; p1 /= den;
                    const half_t* vp = VT + ((size_t)((bb * 2 + kvh) * 64 + lane)) * 2048;
                    float o = 0.f;
                    for (int j = 0; j < 128; ++j) {
                        const int kpos = s - j; if (kpos < 0) break;
                        const float pj = __shfl(j < 64 ? p0 : p1, j & 63);
                        o += pj * (float)vp[kpos];
                    }
                    YA[(size_t)row * 1024 + hh * 64 + lane] = (half_t)o;
                }
            }
        } else if (k == 3) {
            Gemm g; g.K = 256;
            for (int n = 0; n < 4; ++n) g.s[n] = {XC + n * 256, W_g + (size_t)n * 512 * 256, DM, 256};
            SchedGate S{G, c};
            EpiGate E{XC, args.in[I_BRG] + l * DM, args.in[I_BIG] + l * DM, args.in[I_LAM] + l * DM, LA, BI};
            gemm_simple(g, S, E, tid);
        } else if (k == 4) {
            LAS float* sA = (LAS float*)lds; LAS float* sH = sA + 512;
            for (int it = c; it < BATCH * 32; it += G) {
                const int bb = it >> 5, ch = (it & 31) * 32 + (tid & 31), chunk = tid >> 5;
                const size_t o0 = ((size_t)bb * SEQ + chunk * 128) * 1024 + ch;
                float Ap = 1.f, Hh = 0.f;
                for (int t = 0; t < 128; ++t) { const float a = __expf((float)LA[o0 + (size_t)t * 1024]); Hh = a * Hh + (float)BI[o0 + (size_t)t * 1024]; Ap *= a; }
                __syncthreads();
                sA[tid] = Ap; sH[tid] = Hh;
                __syncthreads();
                float h = 0.f;
                for (int j = 0; j < chunk; ++j) h = sA[j * 32 + (tid & 31)] * h + sH[j * 32 + (tid & 31)];
                for (int t = 0; t < 128; ++t) {
                    const float a = __expf((float)LA[o0 + (size_t)t * 1024]); h = a * h + (float)BI[o0 + (size_t)t * 1024];
                    YR[o0 + (size_t)t * 1024] = (half_t)(h * (float)GG[o0 + (size_t)t * 1024]);
                }
            }
        } else if (k == 5) {
            Gemm g; g.K = DM; g.s[0] = {YR, W_br, DM, DM}; g.s[1] = {YA, W_ba, DM, DM}; g.s[2] = g.s[0]; g.s[3] = g.s[0];
            SchedBr S{G, c}; EpiBr E{GR, GA, MG};
            gemm_simple(g, S, E, tid);
        } else if (k == 6 || k == 10 || k == 13) {
            Gemm g; g.K = (k == 13) ? DFF : DM;
            const half_t* A = (k == 6) ? MG : (k == 10) ? OC : HF; const half_t* B = (k == 6) ? W_out : (k == 10) ? W_co : W_fo;
            g.s[0] = {A, B, g.K, g.K}; g.s[1] = g.s[0]; g.s[2] = g.s[0]; g.s[3] = g.s[0];
            SchedMN S{G, c, 4, 256};
            EpiRes E{(l == 0 && k == 6) ? args.in[I_X] : OUT, OUT};
            gemm_simple(g, S, E, tid);
        } else if (k == 7 || k == 11 || k == 14) {
            const int gi = (k == 7) ? I_LN1G : (k == 11) ? I_LN2G : I_LN3G;
            const float* gam = args.in[gi] + l * DM; const float* bet = args.in[gi + 1] + l * DM;
            for (int row = gw; row < M; row += NGW) {
                f32x4* xr = (f32x4*)(OUT + (size_t)row * DM) + lane;
                f32x4 v[4]; float s = 0.f;
#pragma unroll
                for (int j = 0; j < 4; ++j) { v[j] = xr[64 * j]; s += (v[j][0] + v[j][1]) + (v[j][2] + v[j][3]); }
                const float mean = wave_sum(s) * (1.f / DM); float s2 = 0.f;
#pragma unroll
                for (int j = 0; j < 4; ++j) { v[j] = v[j] - mean; s2 += (v[j][0] * v[j][0] + v[j][1] * v[j][1]) + (v[j][2] * v[j][2] + v[j][3] * v[j][3]); }
                const float rstd = 1.f / sqrtf(wave_sum(s2) * (1.f / DM) + LN_EPS);
#pragma unroll
                for (int j = 0; j < 4; ++j) {
                    const f32x4 gg = *((const f32x4*)gam + lane + 64 * j), be = *((const f32x4*)bet + lane + 64 * j);
                    const f32x4 o = v[j] * rstd * gg + be;
                    xr[64 * j] = o;
                    h4 oh; oh[0] = (half_t)o[0]; oh[1] = (half_t)o[1]; oh[2] = (half_t)o[2]; oh[3] = (half_t)o[3];
                    *((h4*)(H16 + (size_t)row * DM) + lane + 64 * j) = oh;
                }
            }
        } else if (k == 8) {
            Gemm g; g.K = DM; g.s[0] = {H16, W_cq, DM, DM}; g.s[1] = g.s[0]; g.s[2] = g.s[0]; g.s[3] = g.s[0];
            SchedMN S{G, c, 4, 256}; EpiScale E{QC, 0.0625f};
            gemm_simple(g, S, E, tid);
        } else if (k == 9) {
            for (int it = gw; it < M * 4; it += NGW) {
                const int row = it >> 2, hh = it & 3, bb = row >> 11;
                const half_t* qp = QC + (size_t)row * 1024 + hh * 256;
                float sc[4];
#pragma unroll
                for (int jj = 0; jj < 4; ++jj) {
                    const half_t* kp = KC + (size_t)(bb * 256 + lane + 64 * jj) * 1024 + hh * 256;
                    float acc = 0.f;
                    for (int d0 = 0; d0 < 256; d0 += 8) { const h8 qv = *(const h8*)(qp + d0), kv = *(const h8*)(kp + d0);
#pragma unroll
                        for (int e = 0; e < 8; ++e) acc += (float)qv[e] * (float)kv[e]; }
                    sc[jj] = acc;
                }
                const float mx = wave_max(fmaxf(fmaxf(sc[0], sc[1]), fmaxf(sc[2], sc[3])));
                float p[4]; float ps = 0.f;
#pragma unroll
                for (int jj = 0; jj < 4; ++jj) { p[jj] = __expf(sc[jj] - mx); ps += p[jj]; }
                const float inv = 1.f / wave_sum(ps);
                const half_t* vp = VCT + ((size_t)((bb * 4 + hh) * 256 + lane * 4)) * 256;
                float o[4] = {0.f, 0.f, 0.f, 0.f};
#pragma unroll
                for (int jj = 0; jj < 4; ++jj) {
                    for (int m0 = 0; m0 < 64; m0 += 8) {
                        float pe[8];
#pragma unroll
                        for (int e = 0; e < 8; ++e) pe[e] = __shfl(p[jj], m0 + e);
#pragma unroll
                        for (int dd = 0; dd < 4; ++dd) { const h8 v = *(const h8*)(vp + (size_t)dd * 256 + jj * 64 + m0);
#pragma unroll
                            for (int e = 0; e < 8; ++e) o[dd] += pe[e] * (float)v[e]; }
                    }
                }
                h4 oh; oh[0] = (half_t)(o[0] * inv); oh[1] = (half_t)(o[1] * inv); oh[2] = (half_t)(o[2] * inv); oh[3] = (half_t)(o[3] * inv);
                *(h4*)(OC + (size_t)row * 1024 + hh * 256 + lane * 4) = oh;
            }
        } else if (k == 12) {
            Gemm g; g.K = DM; g.s[0] = {H16, W_fi, DM, DM}; g.s[1] = g.s[0]; g.s[2] = g.s[0]; g.s[3] = g.s[0];
            SchedMN S{G, c, 22, 64 * 22}; EpiSwiglu E{HF};
            gemm_simple(g, S, E, tid);
        }
    }
}

__global__ void __launch_bounds__(NTHREADS) fwd_kernel(Args args) {
    extern __shared__ __attribute__((aligned(16))) unsigned char lds_raw[];
    cg::grid_group grid = cg::this_grid();
    for (int ph = args.ph_lo; ph < args.ph_hi; ++ph) {
        unsigned char* ws = args.ws; int tid = threadIdx.x;
        asm volatile("" : "+s"(ws)); asm volatile("" : "+v"(tid));
        run_phase(args, ph, ws, tid, (LAS unsigned char*)lds_raw);
        if (ph + 1 < args.ph_hi) grid.sync();
    }
}

extern "C" void kernel_launch(void* const* d_in, const int* in_sizes, int n_in, void* d_out, int out_size, void* d_ws, size_t ws_size, hipStream_t stream) {
    static int grid = 0;
    if (grid == 0) {
        if (n_in != 25 || ws_size < WS_END) { fprintf(stderr, "kernel_launch: unexpected n_in %d / ws_size %zu (need %zu)\n", n_in, ws_size, (size_t)WS_END); grid = -1; return; }
        int dev = 0, cus = 0, per_cu = 0;
        hipGetDevice(&dev); hipDeviceGetAttribute(&cus, hipDeviceAttributeMultiprocessorCount, dev);
        hipFuncSetAttribute((const void*)fwd_kernel, hipFuncAttributeMaxDynamicSharedMemorySize, LDS_BYTES);
        hipOccupancyMaxActiveBlocksPerMultiprocessor(&per_cu, (const void*)fwd_kernel, NTHREADS, LDS_BYTES);
        if (per_cu < 1) per_cu = 1;
        grid = cus * per_cu;
        (void)hipGetLastError();
    }
    if (grid < 0) return;
    Args a{};
    for (int i = 0; i < 25; ++i) a.in[i] = (const float*)d_in[i];
    a.out = (float*)d_out; a.ws = (unsigned char*)d_ws;
    a.ph_lo = 0; a.ph_hi = DEPTH * NPH;
    void* kargs[] = {&a};
    hipError_t e = hipLaunchCooperativeKernel((const void*)fwd_kernel, dim3(grid), dim3(NTHREADS), kargs, LDS_BYTES, stream);
    if (e != hipSuccess) fprintf(stderr, "cooperative launch failed: %s (grid %d)\n", hipGetErrorString(e), grid);
}
```

```cpp
#include <hip/hip_runtime.h>
#include <hip/hip_cooperative_groups.h>
#include <cstdint>
#include <cstdio>
namespace cg = cooperative_groups;

#define LAS __attribute__((address_space(3)))
typedef _Float16 half_t;
typedef _Float16 h8 __attribute__((ext_vector_type(8)));
typedef _Float16 h4 __attribute__((ext_vector_type(4)));
typedef float f32x4 __attribute__((ext_vector_type(4)));
typedef float f32x2 __attribute__((ext_vector_type(2)));

constexpr int DM = 1024, BATCH = 8, SEQ = 2048, DEPTH = 4, M = BATCH * SEQ, MEMLEN = 256, MMEM = BATCH * MEMLEN;
constexpr int INC = 5376, DFF = 2816;
constexpr float ALPHA = 1.681792830507429f, LN_EPS = 1e-5f;
constexpr int NWAVES = 8, NTHREADS = 512;
constexpr int LDS_BYTES = 147456;

constexpr size_t MiB = 1u << 20;
constexpr size_t WS_ROPE = 1 * MiB;
constexpr size_t WS_W = 2 * MiB;
constexpr size_t W_IN = 0, W_G = 11010048, W_BR = W_G + 1 * MiB, W_BA = W_BR + 2 * MiB, W_OUT = W_BA + 2 * MiB, W_CQ = W_OUT + 2 * MiB,
                 W_CO = W_CQ + 2 * MiB, W_CKV = W_CO + 2 * MiB, W_FI = W_CKV + 4 * MiB, W_FO = W_FI + 11534336, W_END = W_FO + 5767168;
static_assert(W_END == 42 * MiB, "weights");
constexpr size_t WS_MEM16 = 86 * MiB, WS_KB = 90 * MiB, WS_VT = 94 * MiB, WS_KC = 98 * MiB, WS_VCT = 102 * MiB, WS_SLOT = 106 * MiB, SLOT = 32 * MiB;
constexpr size_t WS_END = WS_SLOT + 8 * SLOT;

struct Args {
    const float* in[25];
    float* out; unsigned char* ws;
    int ph_lo, ph_hi;
};
enum { I_X = 0, I_MEM, I_WIN, I_CONVW, I_CONVB, I_WRG, I_BRG, I_WIG, I_BIG, I_LAM, I_WBR, I_WBA, I_SINK, I_WOUT, I_LN1G, I_LN1B, I_CQ, I_CKV, I_CO, I_LN2G, I_LN2B,
       I_FWI, I_FWO, I_LN3G, I_LN3B };

__device__ __forceinline__ float wave_sum(float v) {
#pragma unroll
    for (int o = 1; o < 64; o <<= 1) v += __shfl_xor(v, o);
    return v;
}
__device__ __forceinline__ float wave_max(float v) {
#pragma unroll
    for (int o = 1; o < 64; o <<= 1) v = fmaxf(v, __shfl_xor(v, o));
    return v;
}
__device__ __forceinline__ float sigm(float x) { return 1.f / (1.f + __expf(-x)); }
__device__ __forceinline__ float gelu_tanh(float x) {
    const float u = 0.7978845608028654f * (x + 0.044715f * x * x * x);
    const float t = 1.f - 2.f / (__expf(2.f * u) + 1.f);
    return 0.5f * x * (1.f + t);
}
__device__ __forceinline__ h8 pack8(f32x4 a, f32x4 b) {
    h8 v; v[0] = (half_t)a[0]; v[1] = (half_t)a[1]; v[2] = (half_t)a[2]; v[3] = (half_t)a[3]; v[4] = (half_t)b[0]; v[5] = (half_t)b[1]; v[6] = (half_t)b[2]; v[7] = (half_t)b[3];
    return v;
}

struct Unit { int pm, pn, seg; };
struct Gemm { const half_t* A[4]; const half_t* Bt[4]; int lda, ldb, K; };

namespace pg8 {
constexpr int BM = 256, BK = 64, HALF = 128, HTB = HALF * BK * 2, STAGE_BYTES = 8 * HTB;
__device__ __forceinline__ int lds_byte(int r, int c) { const int st = (r >> 4) * 2 + (c >> 5), rr = r & 15, cc = c & 31, ob = rr * 64 + cc * 2; return st * 1024 + (ob ^ (((ob >> 9) & 1) << 5)); }
__device__ __forceinline__ void stage_rc(int b, int& R, int& C) { const int st = b / 1024, sb = b % 1024, swz = sb ^ (((sb >> 9) & 1) << 5); R = (st >> 1) * 16 + swz / 64; C = (st & 1) * 32 + (swz % 64) / 2; }
__device__ __forceinline__ int perm32(int rho) { const int n = rho >> 4, i = rho & 15; return 8 * (i >> 2) + 4 * n + (i & 3); }

template <class Epi, class Sched>
__device__ __forceinline__ void gemm_phase(LAS unsigned char* lds, const Gemm g, const Sched& S, const Epi& E, const int tid) {
    const int wid = __builtin_amdgcn_readfirstlane(tid >> 6), lane = tid & 63, wr = wid >> 2, wc = wid & 3, fr = lane & 15, fq = lane >> 4;
    const int nt = g.K / BK;
    unsigned voffA[2], voffB[2];
#pragma unroll
    for (int i = 0; i < 2; ++i) { int R, C; stage_rc(tid * 16 + i * 8192, R, C); const int Rb = (R & ~31) + perm32(R & 31);
        voffA[i] = (unsigned)(R * g.lda + C) * 2u; voffB[i] = (unsigned)(Rb * g.ldb + C) * 2u; }
    const size_t kstep = (size_t)(BK * 2);
    const size_t hstepA = (size_t)HALF * g.lda * 2, hstepB = (size_t)HALF * g.ldb * 2;
    const unsigned ldsw = (unsigned)wid * 1024u;
    const int aoff = lds_byte(wr * 64 + fr, fq * 8), boff = lds_byte(wc * 32 + fr, fq * 8);
#define PG8_SA(b, h) (((b) * 2 + (h)) * HTB)
#define PG8_SB(b, h) ((4 + (b) * 2 + (h)) * HTB)
#define PG8_STAGE(bufoff, gbase, voff) do { _Pragma("unroll") for (int _i = 0; _i < 2; ++_i) \
        __builtin_amdgcn_global_load_lds((const unsigned*)((const char*)(gbase) + (voff)[_i]), (LAS unsigned*)(lds + (bufoff) + ldsw + _i * 8192), 16, 0, 0); } while (0)
#define PG8_LDA(dst, b, h) do { _Pragma("unroll") for (int m = 0; m < 4; ++m) _Pragma("unroll") for (int k = 0; k < 2; ++k) dst[m][k] = *(const LAS h8*)(lds + PG8_SA(b, h) + aoff + m * 2048 + k * 1024); } while (0)
#define PG8_LDB(dst, b, h) do { _Pragma("unroll") for (int n = 0; n < 2; ++n) _Pragma("unroll") for (int k = 0; k < 2; ++k) dst[n][k] = *(const LAS h8*)(lds + PG8_SB(b, h) + boff + n * 2048 + k * 1024); } while (0)
#define PG8_MMA(ai, bj, At, Bt) do { __builtin_amdgcn_s_setprio(1); _Pragma("unroll") for (int m = 0; m < 4; ++m) _Pragma("unroll") for (int n = 0; n < 2; ++n) _Pragma("unroll") for (int k = 0; k < 2; ++k) \
        acc[ai][bj][m][n] = __builtin_amdgcn_mfma_f32_16x16x32_f16(Bt[n][k], At[m][k], acc[ai][bj][m][n], 0, 0, 0); __builtin_amdgcn_s_setprio(0); } while (0)
#define PG8_WAIT_V(n) asm volatile("s_waitcnt vmcnt(" #n ")" ::: "memory")
#define PG8_WAIT_L(n) asm volatile("s_waitcnt lgkmcnt(" #n ")" ::: "memory")
#define PG8_BAR __builtin_amdgcn_s_barrier()
#define PG8_SCHED __builtin_amdgcn_sched_barrier(0)
#define PG8_ABASE(u) ((const char*)((u).seg == 0 ? g.A[0] : (u).seg == 1 ? g.A[1] : (u).seg == 2 ? g.A[2] : g.A[3]) + (size_t)(u).pm * 2 * hstepA)
#define PG8_BBASE(u) ((const char*)((u).seg == 0 ? g.Bt[0] : (u).seg == 1 ? g.Bt[1] : (u).seg == 2 ? g.Bt[2] : g.Bt[3]) + (size_t)(u).pn * 2 * hstepB)
    Unit cur, nxt; int ui = 0;
    if (!S.next(0, cur)) return;
    f32x4 acc[2][2][4][2];
#pragma unroll
    for (int a = 0; a < 2; ++a)
#pragma unroll
        for (int b = 0; b < 2; ++b)
#pragma unroll
            for (int m = 0; m < 4; ++m)
#pragma unroll
                for (int n = 0; n < 2; ++n) acc[a][b][m][n] = (f32x4){0.f, 0.f, 0.f, 0.f};
    h8 At[4][2], B0[2][2], B1[2][2];
    const char* cA = PG8_ABASE(cur); const char* cB = PG8_BBASE(cur);
    PG8_STAGE(PG8_SB(0, 0), cB, voffB); PG8_STAGE(PG8_SB(0, 1), cB + hstepB, voffB); PG8_STAGE(PG8_SA(0, 0), cA, voffA); PG8_STAGE(PG8_SA(0, 1), cA + hstepA, voffA);
    if (wr == 1) PG8_BAR;
    PG8_WAIT_V(2); PG8_BAR;
    PG8_STAGE(PG8_SB(1, 0), cB + kstep, voffB); PG8_STAGE(PG8_SA(1, 0), cA + kstep, voffA); PG8_STAGE(PG8_SB(1, 1), cB + hstepB + kstep, voffB);
    PG8_WAIT_V(6); PG8_BAR;
    for (;;) {
        const bool has_next = S.next(ui + 1, nxt);
        const char* nA = has_next ? PG8_ABASE(nxt) : cA; const char* nB = has_next ? PG8_BBASE(nxt) : cB;
        for (int t = 0; t < nt; t += 2) {
            const bool last = (t == nt - 2);
            const char* a1 = cA + (size_t)(t + 1) * kstep;
            const char* a2 = last ? nA : cA + (size_t)(t + 2) * kstep; const char* b2 = last ? nB : cB + (size_t)(t + 2) * kstep;
            const char* a3 = a2 + kstep; const char* b3 = b2 + kstep;
            PG8_LDB(B0, 0, 0); PG8_LDB(B1, 0, 1); PG8_SCHED; PG8_LDA(At, 0, 0); PG8_STAGE(PG8_SA(1, 1), a1 + hstepA, voffA);
            PG8_WAIT_V(8); PG8_WAIT_L(0); PG8_BAR; PG8_MMA(0, 0, At, B0); PG8_MMA(0, 1, At, B1); PG8_BAR; PG8_SCHED;
            PG8_LDA(At, 0, 1); PG8_STAGE(PG8_SB(0, 0), b2, voffB); PG8_STAGE(PG8_SB(0, 1), b2 + hstepB, voffB); PG8_STAGE(PG8_SA(0, 0), a2, voffA);
            PG8_WAIT_V(8); PG8_WAIT_L(0); PG8_BAR; PG8_MMA(1, 0, At, B0); PG8_MMA(1, 1, At, B1); PG8_BAR; PG8_SCHED;
            PG8_LDB(B0, 1, 0); PG8_LDB(B1, 1, 1); PG8_SCHED; PG8_LDA(At, 1, 0); PG8_STAGE(PG8_SA(0, 1), a2 + hstepA, voffA);
            PG8_WAIT_V(8); PG8_WAIT_L(0); PG8_BAR; PG8_MMA(0, 0, At, B0); PG8_MMA(0, 1, At, B1); PG8_BAR; PG8_SCHED;
            PG8_LDA(At, 1, 1); PG8_STAGE(PG8_SB(1, 0), b3, voffB); PG8_STAGE(PG8_SB(1, 1), b3 + hstepB, voffB); PG8_STAGE(PG8_SA(1, 0), a3, voffA);
            PG8_WAIT_V(8); PG8_WAIT_L(0); PG8_BAR; PG8_MMA(1, 0, At, B0); PG8_MMA(1, 1, At, B1); PG8_BAR; PG8_SCHED;
        }
        if (wr == 0) PG8_BAR;
        const bool keep = E(acc, cur, wr, wc, fr, fq);
        if (!has_next) break;
        if (!keep) {
#pragma unroll
            for (int a = 0; a < 2; ++a)
#pragma unroll
                for (int b = 0; b < 2; ++b)
#pragma unroll
                    for (int m = 0; m < 4; ++m)
#pragma unroll
                        for (int n = 0; n < 2; ++n) acc[a][b][m][n] = (f32x4){0.f, 0.f, 0.f, 0.f};
        }
        cur = nxt; cA = nA; cB = nB; ++ui;
        if (wr == 1) PG8_BAR;
    }
    PG8_WAIT_V(0);
    PG8_BAR;
#undef PG8_SA
#undef PG8_SB
#undef PG8_STAGE
#undef PG8_LDA
#undef PG8_LDB
#undef PG8_MMA
#undef PG8_WAIT_V
#undef PG8_WAIT_L
#undef PG8_BAR
#undef PG8_SCHED
#undef PG8_ABASE
#undef PG8_BBASE
}
}

struct SchedIn {
    int G, c;
    __device__ __forceinline__ bool next(int i, Unit& u) const {
        const int L = i * G + c; if (L >= 1408) return false;
        if (L < 1344) { u.seg = 0; u.pm = L / 21; u.pn = L % 21; } else { const int r = L - 1344; u.seg = 1; u.pm = r >> 3; u.pn = r & 7; }
        return true;
    }
};
struct SchedGate {
    int G, c;
    __device__ __forceinline__ bool next(int i, Unit& u) const {
        const int L = i * G + c; if (L >= 512) return false;
        u.pn = L & 1; u.seg = (L >> 1) & 3; u.pm = L >> 3; return true;
    }
};
struct SchedBr {
    int G, c;
    __device__ __forceinline__ bool next(int i, Unit& u) const {
        const int t = (i >> 1) * G + c; if (t >= 256) return false;
        u.seg = i & 1; u.pm = t >> 2; u.pn = t & 3; return true;
    }
};
struct SchedMN {
    int G, c, nN, total;
    __device__ __forceinline__ bool next(int i, Unit& u) const {
        const int L = i * G + c; if (L >= total) return false;
        u.seg = 0; u.pm = L / nN; u.pn = L % nN; return true;
    }
};

#define EPI_ROWS for (int ai = 0; ai < 2; ++ai) _Pragma("unroll") for (int m = 0; m < 4; ++m)
struct EpiIn {
    half_t *XR, *GG, *Q, *KB, *VT, *GR, *GA, *KC, *VCT;
    __device__ __forceinline__ bool operator()(f32x4 (&acc)[2][2][4][2], const Unit& u, int wr, int wc, int fr, int fq) const {
        const int pn = u.pn;
#pragma unroll
        EPI_ROWS {
            const int row = u.pm * 256 + ai * 128 + wr * 64 + m * 16 + fr;
#pragma unroll
            for (int bj = 0; bj < 2; ++bj) {
                const int ct = bj * 128 + wc * 32 + fq * 8;
                f32x4 a = acc[ai][bj][m][0], b = acc[ai][bj][m][1];
                if (u.seg == 0) {
                    if (pn < 4) *(h8*)(XR + (size_t)row * 1024 + pn * 256 + ct) = pack8(a, b);
                    else if (pn < 8) {
#pragma unroll
                        for (int e = 0; e < 4; ++e) { a[e] = gelu_tanh(a[e]); b[e] = gelu_tanh(b[e]); }
                        *(h8*)(GG + (size_t)row * 1024 + (pn - 4) * 256 + ct) = pack8(a, b);
                    } else if (pn < 12) *(h8*)(Q + (size_t)row * 1024 + (pn - 8) * 256 + ct) = pack8(a, b);
                    else if (pn == 12) {
                        if (bj == 0) *(h8*)(KB + (size_t)row * 128 + ct) = pack8(a, b);
                        else {
                            const int d0 = ct - 128, kvh = d0 >> 6, dd = d0 & 63, bb = row >> 11, s = row & 2047;
                            half_t* p = VT + ((size_t)((bb * 2 + kvh) * 64 + dd)) * 2048 + s;
                            const h8 v = pack8(a, b);
#pragma unroll
                            for (int e = 0; e < 8; ++e) p[(size_t)e * 2048] = v[e];
                        }
                    } else if (pn < 17) *(h8*)(GR + (size_t)row * 1024 + (pn - 13) * 256 + ct) = pack8(a, b);
                    else *(h8*)(GA + (size_t)row * 1024 + (pn - 17) * 256 + ct) = pack8(a, b);
                } else {
                    if (pn < 4) *(h8*)(KC + (size_t)row * 1024 + pn * 256 + ct) = pack8(a, b);
                    else {
                        const int hh = pn - 4, bb = row >> 8, mm = row & 255;
                        half_t* p = VCT + ((size_t)((bb * 4 + hh) * 256 + ct)) * 256 + mm;
                        const h8 v = pack8(a, b);
#pragma unroll
                        for (int e = 0; e < 8; ++e) p[(size_t)e * 256] = v[e];
                    }
                }
            }
        }
        return false;
    }
};
struct EpiGate {
    const half_t* XC; const float *brg, *big, *lam; half_t *LA, *BI;
    __device__ __forceinline__ bool operator()(f32x4 (&acc)[2][2][4][2], const Unit& u, int wr, int wc, int fr, int fq) const {
        const int ch0 = u.seg * 256 + u.pn * 128 + wc * 32 + fq * 8;
        float sp[8], b1[8], b2[8];
#pragma unroll
        for (int e = 0; e < 8; ++e) { sp[e] = log1pf(__expf(-lam[ch0 + e])); b1[e] = brg[ch0 + e]; b2[e] = big[ch0 + e]; }
#pragma unroll
        EPI_ROWS {
            const int row = u.pm * 256 + ai * 128 + wr * 64 + m * 16 + fr;
            const h8 xc = *(const h8*)(XC + (size_t)row * 1024 + ch0);
            h8 la, bi;
#pragma unroll
            for (int e = 0; e < 8; ++e) {
                const float r = sigm(acc[ai][0][m][e >> 2][e & 3] + b1[e]), ig = sigm(acc[ai][1][m][e >> 2][e & 3] + b2[e]);
                const float l = -8.f * r * sp[e];
                const float mult = sqrtf(-expm1f(2.f * l));
                la[e] = (half_t)l; bi[e] = (half_t)(mult * ig * (float)xc[e]);
            }
            *(h8*)(LA + (size_t)row * 1024 + ch0) = la; *(h8*)(BI + (size_t)row * 1024 + ch0) = bi;
        }
        return false;
    }
};
struct EpiBr {
    const half_t *GR, *GA; half_t* MG;
    __device__ __forceinline__ bool operator()(f32x4 (&acc)[2][2][4][2], const Unit& u, int wr, int wc, int fr, int fq) const {
#pragma unroll
        EPI_ROWS {
            const int row = u.pm * 256 + ai * 128 + wr * 64 + m * 16 + fr;
#pragma unroll
            for (int bj = 0; bj < 2; ++bj) {
                const size_t off = (size_t)row * 1024 + u.pn * 256 + bj * 128 + wc * 32 + fq * 8;
                const h8 ga = *(const h8*)(GA + off);
                if (u.seg == 0) {
                    const h8 gr = *(const h8*)(GR + off);
#pragma unroll
                    for (int e = 0; e < 8; ++e) acc[ai][bj][m][e >> 2][e & 3] *= (1.f + __expf(-(float)ga[e])) / (1.f + __expf(-(float)gr[e]));
                } else {
                    h8 o;
#pragma unroll
                    for (int e = 0; e < 8; ++e) o[e] = (half_t)(acc[ai][bj][m][e >> 2][e & 3] / (1.f + __expf(-(float)ga[e])));
                    *(h8*)(MG + off) = o;
                }
            }
        }
        return u.seg == 0;
    }
};
struct EpiRes {
    const float* base; float* out;
    __device__ __forceinline__ bool operator()(f32x4 (&acc)[2][2][4][2], const Unit& u, int wr, int wc, int fr, int fq) const {
#pragma unroll
        EPI_ROWS {
            const int row = u.pm * 256 + ai * 128 + wr * 64 + m * 16 + fr;
#pragma unroll
            for (int bj = 0; bj < 2; ++bj) {
                const size_t off = (size_t)row * 1024 + u.pn * 256 + bj * 128 + wc * 32 + fq * 8;
                const f32x4 x0 = *(const f32x4*)(base + off), x1 = *(const f32x4*)(base + off + 4);
                *(f32x4*)(out + off) = x0 * ALPHA + acc[ai][bj][m][0]; *(f32x4*)(out + off + 4) = x1 * ALPHA + acc[ai][bj][m][1];
            }
        }
        return false;
    }
};
struct EpiScale {
    half_t* O; float sc;
    __device__ __forceinline__ bool operator()(f32x4 (&acc)[2][2][4][2], const Unit& u, int wr, int wc, int fr, int fq) const {
#pragma unroll
        EPI_ROWS {
            const int row = u.pm * 256 + ai * 128 + wr * 64 + m * 16 + fr;
#pragma unroll
            for (int bj = 0; bj < 2; ++bj) {
                const size_t off = (size_t)row * 1024 + u.pn * 256 + bj * 128 + wc * 32 + fq * 8;
                *(h8*)(O + off) = pack8(acc[ai][bj][m][0] * sc, acc[ai][bj][m][1] * sc);
            }
        }
        return false;
    }
};
struct EpiSwiglu {
    half_t* HF;
    __device__ __forceinline__ bool operator()(f32x4 (&acc)[2][2][4][2], const Unit& u, int wr, int wc, int fr, int fq) const {
#pragma unroll
        EPI_ROWS {
            const int row = u.pm * 256 + ai * 128 + wr * 64 + m * 16 + fr;
            h8 o;
#pragma unroll
            for (int e = 0; e < 8; ++e) { const float gt = acc[ai][0][m][e >> 2][e & 3], up = acc[ai][1][m][e >> 2][e & 3]; o[e] = (half_t)(gt * sigm(gt) * up); }
            *(h8*)(HF + (size_t)row * DFF + u.pn * 128 + wc * 32 + fq * 8) = o;
        }
        return false;
    }
};

__device__ __forceinline__ int rowmap(int kind, int n0) {
    if (kind == 0) return n0;
    if (kind == 1) return (n0 >> 7) * 256 + (n0 & 127);
    if (kind == 2) return (n0 >> 7) * 256 + 128 + (n0 & 127);
    if (n0 < DFF) return (n0 >> 7) * 256 + (n0 & 127);
    const int j = n0 - DFF; return (j >> 7) * 256 + 128 + (j & 127);
}
__device__ __forceinline__ void conv_job(const float* W, int K, int N, half_t* WT, int kind, LAS float* scr, int gw, int NGW, int& base, int lane) {
    const int nblk = N / 32, nitems = (K / 64) * nblk;
    int first = gw - (base % NGW); if (first < 0) first += NGW;
    for (int item = first; item < nitems; item += NGW) {
        const int kb = item / nblk, nb = item % nblk, k0 = 64 * kb, n0 = 32 * nb;
#pragma unroll 8
        for (int i = 0; i < 32; ++i) { const int kk = 2 * i + (lane >> 5); scr[kk * 33 + (lane & 31)] = W[(size_t)(k0 + kk) * N + n0 + (lane & 31)]; }
        asm volatile("s_waitcnt lgkmcnt(0)" ::: "memory");
        const int c = lane & 7, r0 = rowmap(kind, n0);
#pragma unroll
        for (int j = 0; j < 4; ++j) {
            const int n = (lane >> 3) + 8 * j; const LAS float* s = scr + (8 * c) * 33 + n;
            h8 o;
#pragma unroll
            for (int e = 0; e < 8; ++e) o[e] = (half_t)s[e * 33];
            *(h8*)(WT + (size_t)(r0 + n) * K + k0 + 8 * c) = o;
        }
        asm volatile("s_waitcnt lgkmcnt(0)" ::: "memory");
    }
    base += nitems;
}

typedef unsigned u32x4 __attribute__((ext_vector_type(4)));
__device__ __forceinline__ h8 hcat(h4 lo, h4 hi) { h8 v; v[0] = lo[0]; v[1] = lo[1]; v[2] = lo[2]; v[3] = lo[3]; v[4] = hi[0]; v[5] = hi[1]; v[6] = hi[2]; v[7] = hi[3]; return v; }
__device__ __forceinline__ h8 pack8s(f32x4 a, f32x4 b) { return pack8(a, b); }
__device__ __forceinline__ void swa_phase(LAS unsigned char* lds, const half_t* Q, const half_t* KB, const half_t* VT, half_t* YA, const f32x2* ROPE, const float* sinks, const int tid, const int c, const int G) {
    const int wid = __builtin_amdgcn_readfirstlane(tid >> 6), lane = tid & 63, j = lane & 15, g = lane >> 4;
    LAS half_t* Kl = (LAS half_t*)lds;
    LAS half_t* Vl = Kl + 256 * 72;
    for (int it = c; it < 256; it += G) {
        const int bb = it >> 5, nb = (it >> 1) & 15, kvh = it & 1;
#pragma unroll
        for (int r = 0; r < 2; ++r) {
            const int idx = tid + 512 * r, row = idx >> 2, cp = idx & 3, kpos = (nb - 1) * 128 + row;
            h8 c0, c1;
#pragma unroll
            for (int e = 0; e < 8; ++e) { c0[e] = (half_t)0.f; c1[e] = (half_t)0.f; }
            if (kpos >= 0) {
                const half_t* kp = KB + (size_t)(bb * 2048 + kpos) * 128 + kvh * 64 + cp * 16;
                c0 = *(const h8*)kp; c1 = *(const h8*)(kp + 8);
                if (cp == 0) {
#pragma unroll
                    for (int e = 0; e < 8; ++e) { const f32x2 cs = ROPE[kpos * 8 + e]; const float t1 = (float)c0[e], t2 = (float)c1[e]; c0[e] = (half_t)(t1 * cs.x - t2 * cs.y); c1[e] = (half_t)(t2 * cs.x + t1 * cs.y); }
                }
            }
            *(LAS h8*)(Kl + row * 72 + cp * 16) = c0; *(LAS h8*)(Kl + row * 72 + cp * 16 + 8) = c1;
        }
#pragma unroll
        for (int r = 0; r < 4; ++r) {
            const int idx = tid + 512 * r, d = idx >> 5, ch = idx & 31;
            h8 v;
#pragma unroll
            for (int e = 0; e < 8; ++e) v[e] = (half_t)0.f;
            if (nb > 0 || ch >= 16) v = *(const h8*)(VT + ((size_t)((bb * 2 + kvh) * 64 + d)) * 2048 + (nb - 1) * 128 + ch * 8);
            *(LAS h8*)(Vl + d * 264 + ch * 8) = v;
        }
        __syncthreads();
        const int kb0 = wid < 6 ? wid : 6;
        const int iq = 16 * wid + j;
        const size_t row = (size_t)bb * 2048 + nb * 128 + iq;
        for (int hg = 0; hg < 8; ++hg) {
            const int hh = kvh * 8 + hg;
            const half_t* qp = Q + row * 1024 + hh * 64 + 8 * g;
            h8 qf0 = *(const h8*)qp, qf1 = *(const h8*)(qp + 32);
            {
                u32x4 self = __builtin_bit_cast(u32x4, qf0), oth;
#pragma unroll
                for (int e = 0; e < 4; ++e) oth[e] = (unsigned)__shfl_xor((int)self[e], 16);
                const h8 ot = __builtin_bit_cast(h8, oth);
                if (g < 2) {
                    const float sgn = (g == 0) ? -1.f : 1.f;
#pragma unroll
                    for (int e = 0; e < 8; ++e) { const f32x2 cs = ROPE[(nb * 128 + iq) * 8 + e]; qf0[e] = (half_t)((float)qf0[e] * cs.x + sgn * (float)ot[e] * cs.y); }
                }
            }
#pragma unroll
            for (int e = 0; e < 8; ++e) { qf0[e] = qf0[e] * (half_t)0.125f; qf1[e] = qf1[e] * (half_t)0.125f; }
            f32x4 sc[10];
#pragma unroll
            for (int kb = 0; kb < 10; ++kb) {
                const LAS half_t* kp = Kl + (16 * (kb0 + kb) + j) * 72 + 8 * g;
                f32x4 a = (f32x4){0.f, 0.f, 0.f, 0.f};
                a = __builtin_amdgcn_mfma_f32_16x16x32_f16(*(const LAS h8*)kp, qf0, a, 0, 0, 0);
                a = __builtin_amdgcn_mfma_f32_16x16x32_f16(*(const LAS h8*)(kp + 32), qf1, a, 0, 0, 0);
                sc[kb] = a;
            }
            const float sk = sinks[hh];
            float mx = sk;
#pragma unroll
            for (int kb = 0; kb < 10; ++kb)
#pragma unroll
                for (int r = 0; r < 4; ++r) {
                    const int jk = 16 * (kb0 + kb) + 4 * g + r;
                    const bool valid = (jk > iq) && (jk <= iq + 128) && (nb > 0 || jk >= 128);
                    sc[kb][r] = valid ? sc[kb][r] : -1e30f; mx = fmaxf(mx, sc[kb][r]);
                }
            mx = fmaxf(mx, __shfl_xor(mx, 16)); mx = fmaxf(mx, __shfl_xor(mx, 32));
            float sum = 0.f;
#pragma unroll
            for (int kb = 0; kb < 10; ++kb)
#pragma unroll
                for (int r = 0; r < 4; ++r) { const float pv = __expf(sc[kb][r] - mx); sc[kb][r] = pv; sum += pv; }
            sum += __shfl_xor(sum, 16); sum += __shfl_xor(sum, 32); sum += __expf(sk - mx);
            f32x4 o[4];
#pragma unroll
            for (int db = 0; db < 4; ++db) o[db] = (f32x4){0.f, 0.f, 0.f, 0.f};
#pragma unroll
            for (int pp = 0; pp < 5; ++pp) {
                const h8 pb = pack8(sc[2 * pp], sc[2 * pp + 1]);
#pragma unroll
                for (int db = 0; db < 4; ++db) {
                    const LAS half_t* vp = Vl + (16 * db + j) * 264 + 16 * (kb0 + 2 * pp) + 4 * g;
                    const h8 av = hcat(*(const LAS h4*)vp, *(const LAS h4*)(vp + 16));
                    o[db] = __builtin_amdgcn_mfma_f32_16x16x32_f16(av, pb, o[db], 0, 0, 0);
                }
            }
            const float inv = 1.f / sum;
#pragma unroll
            for (int db = 0; db < 4; ++db) {
                h4 oh; oh[0] = (half_t)(o[db][0] * inv); oh[1] = (half_t)(o[db][1] * inv); oh[2] = (half_t)(o[db][2] * inv); oh[3] = (half_t)(o[db][3] * inv);
                *(h4*)(YA + row * 1024 + hh * 64 + 16 * db + 4 * g) = oh;
            }
        }
        __syncthreads();
    }
}
__device__ __forceinline__ void cross_phase(LAS unsigned char* lds, const half_t* QC, const half_t* KC, const half_t* VCT, half_t* OC, const int tid, const int c, const int G) {
    const int wid = __builtin_amdgcn_readfirstlane(tid >> 6), lane = tid & 63, j = lane & 15, g = lane >> 4;
    LAS half_t* Kl = (LAS half_t*)lds;
    for (int it = c; it < 512; it += G) {
        const int bb = it >> 6, hh = (it >> 4) & 3, qb = it & 15;
#pragma unroll
        for (int r = 0; r < 16; ++r) {
            const int idx = tid + 512 * r, m = idx >> 5, ch = idx & 31;
            *(LAS h8*)(Kl + m * 264 + ch * 8) = *(const h8*)(KC + (size_t)(bb * 256 + m) * 1024 + hh * 256 + ch * 8);
        }
        const size_t row = (size_t)bb * 2048 + qb * 128 + 16 * wid + j;
        h8 qf[8];
#pragma unroll
        for (int ks = 0; ks < 8; ++ks) qf[ks] = *(const h8*)(QC + row * 1024 + hh * 256 + 32 * ks + 8 * g);
        __syncthreads();
        f32x4 sc[16];
#pragma unroll
        for (int kb = 0; kb < 16; ++kb) {
            const LAS half_t* kp = Kl + (16 * kb + j) * 264 + 8 * g;
            f32x4 a = (f32x4){0.f, 0.f, 0.f, 0.f};
#pragma unroll
            for (int ks = 0; ks < 8; ++ks) a = __builtin_amdgcn_mfma_f32_16x16x32_f16(*(const LAS h8*)(kp + 32 * ks), qf[ks], a, 0, 0, 0);
            sc[kb] = a;
        }
        float mx = -1e30f;
#pragma unroll
        for (int kb = 0; kb < 16; ++kb)
#pragma unroll
            for (int r = 0; r < 4; ++r) mx = fmaxf(mx, sc[kb][r]);
        mx = fmaxf(mx, __shfl_xor(mx, 16)); mx = fmaxf(mx, __shfl_xor(mx, 32));
        float sum = 0.f;
#pragma unroll
        for (int kb = 0; kb < 16; ++kb)
#pragma unroll
            for (int r = 0; r < 4; ++r) { const float pv = __expf(sc[kb][r] - mx); sc[kb][r] = pv; sum += pv; }
        sum += __shfl_xor(sum, 16); sum += __shfl_xor(sum, 32);
        h8 pb[8];
#pragma unroll
        for (int pp = 0; pp < 8; ++pp) pb[pp] = pack8(sc[2 * pp], sc[2 * pp + 1]);
        __syncthreads();
#pragma unroll
        for (int r = 0; r < 16; ++r) {
            const int idx = tid + 512 * r, d = idx >> 5, ch = idx & 31;
            *(LAS h8*)(Kl + d * 264 + ch * 8) = *(const h8*)(VCT + ((size_t)((bb * 4 + hh) * 256 + d)) * 256 + ch * 8);
        }
        __syncthreads();
        const float inv = 1.f / sum;
#pragma unroll
        for (int db = 0; db < 16; ++db) {
            f32x4 o = (f32x4){0.f, 0.f, 0.f, 0.f};
#pragma unroll
            for (int pp = 0; pp < 8; ++pp) {
                const LAS half_t* vp = Kl + (16 * db + j) * 264 + 32 * pp + 4 * g;
                o = __builtin_amdgcn_mfma_f32_16x16x32_f16(hcat(*(const LAS h4*)vp, *(const LAS h4*)(vp + 16)), pb[pp], o, 0, 0, 0);
            }
            h4 oh; oh[0] = (half_t)(o[0] * inv); oh[1] = (half_t)(o[1] * inv); oh[2] = (half_t)(o[2] * inv); oh[3] = (half_t)(o[3] * inv);
            *(h4*)(OC + row * 1024 + hh * 256 + 16 * db + 4 * g) = oh;
        }
        __syncthreads();
    }
}

constexpr int NPH = 15;
__constant__ double INVF[8] = {1.0, 0.19392274474868576, 0.03760603093086393, 0.007292664737217109, 0.001414213562373095, 0.0002742481756762073, 5.318295896944988e-05, 1.031338537721246e-05};
__device__ __forceinline__ void sincos_d(double ang, float& c, float& s) {
    const double n = __builtin_rint(ang * 0.6366197723675814);
    double r = __builtin_fma(-n, 1.5707963267948966, ang); r = __builtin_fma(-n, 6.123233995736766e-17, r);
    const double r2 = r * r;
    double sp = r * (1.0 + r2 * (-1.0 / 6 + r2 * (1.0 / 120 + r2 * (-1.0 / 5040 + r2 * (1.0 / 362880 + r2 * (-1.0 / 39916800 + r2 * (1.0 / 6227020800.0)))))));
    double cp = 1.0 + r2 * (-0.5 + r2 * (1.0 / 24 + r2 * (-1.0 / 720 + r2 * (1.0 / 40320 + r2 * (-1.0 / 3628800 + r2 * (1.0 / 479001600 + r2 * (-1.0 / 87178291200.0)))))));
    const int q = ((int)n) & 3;
    const double cc = (q == 0) ? cp : (q == 1) ? -sp : (q == 2) ? -cp : sp;
    const double ss = (q == 0) ? sp : (q == 1) ? cp : (q == 2) ? -sp : -cp;
    c = (float)cc; s = (float)ss;
}

__device__ __forceinline__ void run_phase(const Args& args, const int ph, unsigned char* ws, const int tid, LAS unsigned char* lds) {
    const int lane = tid & 63, wid = __builtin_amdgcn_readfirstlane(tid >> 6);
    const int G = gridDim.x, c = blockIdx.x, gw = c * NWAVES + wid, NGW = G * NWAVES;
    f32x2* ROPE = (f32x2*)(ws + WS_ROPE);
    half_t *W_in = (half_t*)(ws + WS_W + W_IN), *W_g = (half_t*)(ws + WS_W + W_G), *W_br = (half_t*)(ws + WS_W + W_BR), *W_ba = (half_t*)(ws + WS_W + W_BA),
           *W_out = (half_t*)(ws + WS_W + W_OUT), *W_cq = (half_t*)(ws + WS_W + W_CQ), *W_co = (half_t*)(ws + WS_W + W_CO), *W_ckv = (half_t*)(ws + WS_W + W_CKV),
           *W_fi = (half_t*)(ws + WS_W + W_FI), *W_fo = (half_t*)(ws + WS_W + W_FO);
    half_t *MEM16 = (half_t*)(ws + WS_MEM16), *KB = (half_t*)(ws + WS_KB), *VT = (half_t*)(ws + WS_VT), *KC = (half_t*)(ws + WS_KC), *VCT = (half_t*)(ws + WS_VCT);
#define SLOTP(i) ((half_t*)(ws + WS_SLOT + (size_t)(i) * SLOT))
    half_t *H16 = SLOTP(0), *XR = SLOTP(1), *LA = SLOTP(1), *MG = SLOTP(1), *GG = SLOTP(2), *QC = SLOTP(2), *Q = SLOTP(3), *BI = SLOTP(3), *OC = SLOTP(3),
           *GR = SLOTP(4), *GA = SLOTP(5), *XC = SLOTP(6), *YR = SLOTP(6), *YA = SLOTP(7), *HF = SLOTP(4);
    float* OUT = args.out;
    {
        const int l = ph / NPH, k = ph % NPH;
        if (k == 0) {
            LAS float* scr = (LAS float*)(lds + wid * 16384);
            int base = 0;
            conv_job(args.in[I_WIN] + (size_t)l * DM * INC, DM, INC, W_in, 0, scr, gw, NGW, base, lane);
            conv_job(args.in[I_FWI] + (size_t)l * DM * 2 * DFF, DM, 2 * DFF, W_fi, 3, scr, gw, NGW, base, lane);
            conv_job(args.in[I_FWO] + (size_t)l * DFF * DM, DFF, DM, W_fo, 0, scr, gw, NGW, base, lane);
            conv_job(args.in[I_CKV] + (size_t)l * DM * 2048, DM, 2048, W_ckv, 0, scr, gw, NGW, base, lane);
            conv_job(args.in[I_WBR] + (size_t)l * DM * DM, DM, DM, W_br, 0, scr, gw, NGW, base, lane);
            conv_job(args.in[I_WBA] + (size_t)l * DM * DM, DM, DM, W_ba, 0, scr, gw, NGW, base, lane);
            conv_job(args.in[I_WOUT] + (size_t)l * DM * DM, DM, DM, W_out, 0, scr, gw, NGW, base, lane);
            conv_job(args.in[I_CQ] + (size_t)l * DM * DM, DM, DM, W_cq, 0, scr, gw, NGW, base, lane);
            conv_job(args.in[I_CO] + (size_t)l * DM * DM, DM, DM, W_co, 0, scr, gw, NGW, base, lane);
            for (int n = 0; n < 4; ++n) {
                conv_job(args.in[I_WRG] + (size_t)(l * 4 + n) * 65536, 256, 256, W_g + (size_t)n * 512 * 256, 1, scr, gw, NGW, base, lane);
                conv_job(args.in[I_WIG] + (size_t)(l * 4 + n) * 65536, 256, 256, W_g + (size_t)n * 512 * 256, 2, scr, gw, NGW, base, lane);
            }
            if (l == 0) {
                const int gt = c * NTHREADS + tid, NGT = G * NTHREADS;
                const float* x = args.in[I_X]; const float* mem = args.in[I_MEM];
                for (int i = gt; i < M * DM / 8; i += NGT) { const f32x4 a = *(const f32x4*)(x + (size_t)i * 8), b = *(const f32x4*)(x + (size_t)i * 8 + 4); *(h8*)(H16 + (size_t)i * 8) = pack8(a, b); }
                for (int i = gt; i < MMEM * DM / 8; i += NGT) { const f32x4 a = *(const f32x4*)(mem + (size_t)i * 8), b = *(const f32x4*)(mem + (size_t)i * 8 + 4); *(h8*)(MEM16 + (size_t)i * 8) = pack8(a, b); }
            }
        } else if (k == 1) {
            Gemm g; g.K = DM; g.lda = DM; g.ldb = DM; g.A[0] = H16; g.Bt[0] = W_in; g.A[1] = MEM16; g.Bt[1] = W_ckv; g.A[2] = H16; g.Bt[2] = W_in; g.A[3] = H16; g.Bt[3] = W_in;
            SchedIn S{G, c}; EpiIn E{XR, GG, Q, KB, VT, GR, GA, KC, VCT};
            pg8::gemm_phase(lds, g, S, E, tid);
        } else if (k == 2) {
            {
                const float* cw = args.in[I_CONVW] + (size_t)l * 4 * DM; const float* cb = args.in[I_CONVB] + (size_t)l * DM;
                const int gt = c * NTHREADS + tid, NGT = G * NTHREADS;
                for (int i = gt; i < M * 128; i += NGT) {
                    const int row = i >> 7, ch = (i & 127) * 8, s = row & 2047;
                    float a[8];
#pragma unroll
                    for (int e = 0; e < 8; ++e) a[e] = cb[ch + e];
#pragma unroll
                    for (int kk = 0; kk < 4; ++kk) {
                        if (s - 3 + kk >= 0) {
                            const h8 v = *(const h8*)(XR + (size_t)(row - 3 + kk) * 1024 + ch);
#pragma unroll
                            for (int e = 0; e < 8; ++e) a[e] += (float)v[e] * cw[kk * DM + ch + e];
                        }
                    }
                    h8 o;
#pragma unroll
                    for (int e = 0; e < 8; ++e) o[e] = (half_t)a[e];
                    *(h8*)(XC + (size_t)row * 1024 + ch) = o;
                }
            }
            swa_phase(lds, Q, KB, VT, YA, ROPE, args.in[I_SINK] + l * 16, tid, c, G);
        } else if (k == 3) {
            Gemm g; g.K = 256; g.lda = DM; g.ldb = 256;
#pragma unroll
            for (int n = 0; n < 4; ++n) { g.A[n] = XC + n * 256; g.Bt[n] = W_g + (size_t)n * 512 * 256; }
            SchedGate S{G, c};
            EpiGate E{XC, args.in[I_BRG] + l * DM, args.in[I_BIG] + l * DM, args.in[I_LAM] + l * DM, LA, BI};
            pg8::gemm_phase(lds, g, S, E, tid);
        } else if (k == 4) {
            LAS float* sA = (LAS float*)lds; LAS float* sH = sA + 512;
            for (int it = c; it < BATCH * 32; it += G) {
                const int bb = it >> 5, ch = (it & 31) * 32 + (tid & 31), chunk = tid >> 5;
                const size_t o0 = ((size_t)bb * SEQ + chunk * 128) * 1024 + ch;
                float Ap = 1.f, Hh = 0.f;
#pragma unroll 16
                for (int t = 0; t < 128; ++t) { const float a = __expf((float)LA[o0 + (size_t)t * 1024]); Hh = a * Hh + (float)BI[o0 + (size_t)t * 1024]; Ap *= a; }
                __syncthreads();
                sA[tid] = Ap; sH[tid] = Hh;
                __syncthreads();
                float h = 0.f;
                for (int j = 0; j < chunk; ++j) h = sA[j * 32 + (tid & 31)] * h + sH[j * 32 + (tid & 31)];
#pragma unroll 16
                for (int t = 0; t < 128; ++t) {
                    const float a = __expf((float)LA[o0 + (size_t)t * 1024]); h = a * h + (float)BI[o0 + (size_t)t * 1024];
                    YR[o0 + (size_t)t * 1024] = (half_t)(h * (float)GG[o0 + (size_t)t * 1024]);
                }
            }
        } else if (k == 5) {
            Gemm g; g.K = DM; g.lda = DM; g.ldb = DM; g.A[0] = YR; g.Bt[0] = W_br; g.A[1] = YA; g.Bt[1] = W_ba; g.A[2] = YR; g.Bt[2] = W_br; g.A[3] = YR; g.Bt[3] = W_br;
            SchedBr S{G, c}; EpiBr E{GR, GA, MG};
            pg8::gemm_phase(lds, g, S, E, tid);
        } else if (k == 6 || k == 10 || k == 13) {
            Gemm g; g.K = (k == 13) ? DFF : DM;
            const half_t* A = (k == 6) ? MG : (k == 10) ? OC : HF; const half_t* B = (k == 6) ? W_out : (k == 10) ? W_co : W_fo;
            g.lda = g.K; g.ldb = g.K;
#pragma unroll
            for (int n = 0; n < 4; ++n) { g.A[n] = A; g.Bt[n] = B; }
            SchedMN S{G, c, 4, 256};
            EpiRes E{(l == 0 && k == 6) ? args.in[I_X] : OUT, OUT};
            pg8::gemm_phase(lds, g, S, E, tid);
        } else if (k == 7 || k == 11 || k == 14) {
            const int gi = (k == 7) ? I_LN1G : (k == 11) ? I_LN2G : I_LN3G;
            const float* gam = args.in[gi] + l * DM; const float* bet = args.in[gi + 1] + l * DM;
            for (int row = gw; row < M; row += NGW) {
                f32x4* xr = (f32x4*)(OUT + (size_t)row * DM) + lane;
                f32x4 v[4]; float s = 0.f;
#pragma unroll
                for (int j = 0; j < 4; ++j) { v[j] = xr[64 * j]; s += (v[j][0] + v[j][1]) + (v[j][2] + v[j][3]); }
                const float mean = wave_sum(s) * (1.f / DM); float s2 = 0.f;
#pragma unroll
                for (int j = 0; j < 4; ++j) { v[j] = v[j] - mean; s2 += (v[j][0] * v[j][0] + v[j][1] * v[j][1]) + (v[j][2] * v[j][2] + v[j][3] * v[j][3]); }
                const float rstd = 1.f / sqrtf(wave_sum(s2) * (1.f / DM) + LN_EPS);
#pragma unroll
                for (int j = 0; j < 4; ++j) {
                    const f32x4 gg = *((const f32x4*)gam + lane + 64 * j), be = *((const f32x4*)bet + lane + 64 * j);
                    const f32x4 o = v[j] * rstd * gg + be;
                    xr[64 * j] = o;
                    h4 oh; oh[0] = (half_t)o[0]; oh[1] = (half_t)o[1]; oh[2] = (half_t)o[2]; oh[3] = (half_t)o[3];
                    *((h4*)(H16 + (size_t)row * DM) + lane + 64 * j) = oh;
                }
            }
        } else if (k == 8) {
            Gemm g; g.K = DM; g.lda = DM; g.ldb = DM;
#pragma unroll
            for (int n = 0; n < 4; ++n) { g.A[n] = H16; g.Bt[n] = W_cq; }
            SchedMN S{G, c, 4, 256}; EpiScale E{QC, 0.0625f};
            pg8::gemm_phase(lds, g, S, E, tid);
        } else if (k == 9) {
            cross_phase(lds, QC, KC, VCT, OC, tid, c, G);
        } else if (k == 12) {
            Gemm g; g.K = DM; g.lda = DM; g.ldb = DM;
#pragma unroll
            for (int n = 0; n < 4; ++n) { g.A[n] = H16; g.Bt[n] = W_fi; }
            SchedMN S{G, c, 22, 64 * 22}; EpiSwiglu E{HF};
            pg8::gemm_phase(lds, g, S, E, tid);
        }
    }
}

__global__ void __launch_bounds__(NTHREADS) fwd_kernel(Args args) {
    extern __shared__ __attribute__((aligned(16))) unsigned char lds_raw[];
    cg::grid_group grid = cg::this_grid();
    if (args.ph_lo == 0) {
        f32x2* ROPE = (f32x2*)(args.ws + WS_ROPE);
        for (int i = blockIdx.x * NTHREADS + threadIdx.x; i < SEQ * 8; i += gridDim.x * NTHREADS) {
            float cs, sn; sincos_d((double)(i >> 3) * INVF[i & 7], cs, sn);
            ROPE[i] = (f32x2){cs, sn};
        }
    }
    for (int ph = args.ph_lo; ph < args.ph_hi; ++ph) {
        unsigned char* ws = args.ws; int tid = threadIdx.x;
        asm volatile("" : "+s"(ws)); asm volatile("" : "+v"(tid));
        run_phase(args, ph, ws, tid, (LAS unsigned char*)lds_raw);
        if (ph + 1 < args.ph_hi) grid.sync();
    }
}

extern "C" void kernel_launch(void* const* d_in, const int* in_sizes, int n_in, void* d_out, int out_size, void* d_ws, size_t ws_size, hipStream_t stream) {
    static int grid = 0;
    if (grid == 0) {
        if (n_in != 25 || ws_size < WS_END) { fprintf(stderr, "kernel_launch: unexpected n_in %d / ws_size %zu (need %zu)\n", n_in, ws_size, (size_t)WS_END); grid = -1; return; }
        int dev = 0, cus = 0, per_cu = 0;
        hipGetDevice(&dev); hipDeviceGetAttribute(&cus, hipDeviceAttributeMultiprocessorCount, dev);
        hipFuncSetAttribute((const void*)fwd_kernel, hipFuncAttributeMaxDynamicSharedMemorySize, LDS_BYTES);
        hipOccupancyMaxActiveBlocksPerMultiprocessor(&per_cu, (const void*)fwd_kernel, NTHREADS, LDS_BYTES);
        if (per_cu < 1) per_cu = 1;
        grid = cus * per_cu;
        (void)hipGetLastError();
    }
    if (grid < 0) return;
    Args a{};
    for (int i = 0; i < 25; ++i) a.in[i] = (const float*)d_in[i];
    a.out = (float*)d_out; a.ws = (unsigned char*)d_ws;
    a.ph_lo = 0; a.ph_hi = DEPTH * NPH;
    void* kargs[] = {&a};
    hipError_t e = hipLaunchCooperativeKernel((const void*)fwd_kernel, dim3(grid), dim3(NTHREADS), kargs, LDS_BYTES, stream);
    if (e != hipSuccess) fprintf(stderr, "cooperative launch failed: %s (grid %d)\n", hipGetErrorString(e), grid);
}
```

```cpp
#include <hip/hip_runtime.h>
#include <hip/hip_cooperative_groups.h>
#include <cstdint>
#include <cstdio>
namespace cg = cooperative_groups;

#define LAS __attribute__((address_space(3)))
typedef _Float16 half_t;
typedef _Float16 h8 __attribute__((ext_vector_type(8)));
typedef _Float16 h4 __attribute__((ext_vector_type(4)));
typedef float f32x4 __attribute__((ext_vector_type(4)));
typedef float f32x2 __attribute__((ext_vector_type(2)));

constexpr int DM = 1024, BATCH = 8, SEQ = 2048, DEPTH = 4, M = BATCH * SEQ, MEMLEN = 256, MMEM = BATCH * MEMLEN;
constexpr int INC = 5376, DFF = 2816;
constexpr float ALPHA = 1.681792830507429f, LN_EPS = 1e-5f;
constexpr int NWAVES = 8, NTHREADS = 512;
constexpr int LDS_BYTES = 147456;

constexpr size_t MiB = 1u << 20;
constexpr size_t WS_ROPE = 1 * MiB;
constexpr size_t WS_W = 2 * MiB;
constexpr size_t W_IN = 0, W_G = 11010048, W_BR = W_G + 1 * MiB, W_BA = W_BR + 2 * MiB, W_OUT = W_BA + 2 * MiB, W_CQ = W_OUT + 2 * MiB,
                 W_CO = W_CQ + 2 * MiB, W_CKV = W_CO + 2 * MiB, W_FI = W_CKV + 4 * MiB, W_FO = W_FI + 11534336, W_END = W_FO + 5767168;
static_assert(W_END == 42 * MiB, "weights");
constexpr size_t WS_MEM16 = 86 * MiB, WS_KB = 90 * MiB, WS_VT = 94 * MiB, WS_KC = 98 * MiB, WS_VCT = 102 * MiB, WS_SLOT = 106 * MiB, SLOT = 32 * MiB;
constexpr size_t WS_END = WS_SLOT + 8 * SLOT;

struct Args {
    const float* in[25];
    float* out; unsigned char* ws;
    int ph_lo, ph_hi;
};
enum { I_X = 0, I_MEM, I_WIN, I_CONVW, I_CONVB, I_WRG, I_BRG, I_WIG, I_BIG, I_LAM, I_WBR, I_WBA, I_SINK, I_WOUT, I_LN1G, I_LN1B, I_CQ, I_CKV, I_CO, I_LN2G, I_LN2B,
       I_FWI, I_FWO, I_LN3G, I_LN3B };

__device__ __forceinline__ float zf() { float z = 0.f; asm volatile("" : "+v"(z)); return z; }
__device__ __forceinline__ int shx_i(int v, int mask, int lane) { return __builtin_amdgcn_ds_bpermute((lane ^ mask) << 2, v); }
__device__ __forceinline__ float shx(float v, int mask, int lane) { return __builtin_bit_cast(float, __builtin_amdgcn_ds_bpermute((lane ^ mask) << 2, __builtin_bit_cast(int, v))); }
__device__ __forceinline__ float wave_sum(float v, int lane) {
#pragma unroll
    for (int o = 1; o < 64; o <<= 1) v += shx(v, o, lane);
    return v;
}
__device__ __forceinline__ float rcpf_(float x) { return __builtin_amdgcn_rcpf(x); }
__device__ __forceinline__ float sigm(float x) { return rcpf_(1.f + __expf(-x)); }
__device__ __forceinline__ float one_minus_exp(float y) {
    const float ser = -y * (1.f + y * 0.5f * (1.f + y * (1.f / 3) * (1.f + y * 0.25f * (1.f + y * 0.2f * (1.f + y * (1.f / 6) * (1.f + y * (1.f / 7)))))));
    return (y > -0.5f) ? ser : 1.f - __expf(y);
}
__device__ __forceinline__ float softplus_neg(float x) {
    const float t = __expf(-x);
    const float ser = t * (1.f - t * (0.5f - t * ((1.f / 3) - t * (0.25f - t * (0.2f - t * ((1.f / 6) - t * (1.f / 7)))))));
    return (t < 0.0625f) ? ser : __logf(1.f + t);
}
__device__ __forceinline__ float gelu_tanh(float x) {
    const float u = 0.7978845608028654f * (x + 0.044715f * x * x * x);
    const float t = 1.f - 2.f * rcpf_(__expf(2.f * u) + 1.f);
    return 0.5f * x * (1.f + t);
}
__device__ __forceinline__ h8 pack8(f32x4 a, f32x4 b) {
    h8 v; v[0] = (half_t)a[0]; v[1] = (half_t)a[1]; v[2] = (half_t)a[2]; v[3] = (half_t)a[3]; v[4] = (half_t)b[0]; v[5] = (half_t)b[1]; v[6] = (half_t)b[2]; v[7] = (half_t)b[3];
    return v;
}

struct Unit { int pm, pn, seg; };
struct Gemm { const half_t* A[4]; const half_t* Bt[4]; int lda, ldb, K; };

namespace pg8 {
constexpr int BM = 256, BK = 64, HALF = 128, HTB = HALF * BK * 2, STAGE_BYTES = 8 * HTB;
__device__ __forceinline__ int lds_byte(int r, int c) { const int st = (r >> 4) * 2 + (c >> 5), rr = r & 15, cc = c & 31, ob = rr * 64 + cc * 2; return st * 1024 + (ob ^ (((ob >> 9) & 1) << 5)); }
__device__ __forceinline__ void stage_rc(int b, int& R, int& C) { const int st = b / 1024, sb = b % 1024, swz = sb ^ (((sb >> 9) & 1) << 5); R = (st >> 1) * 16 + swz / 64; C = (st & 1) * 32 + (swz % 64) / 2; }
__device__ __forceinline__ int perm32(int rho) { const int n = rho >> 4, i = rho & 15; return 8 * (i >> 2) + 4 * n + (i & 3); }

template <class Epi, class Sched>
__device__ __forceinline__ void gemm_phase(LAS unsigned char* lds, const Gemm g, const Sched& S, const Epi& E, const int tid) {
    const int wid = __builtin_amdgcn_readfirstlane(tid >> 6), lane = tid & 63, wr = wid >> 2, wc = wid & 3, fr = lane & 15, fq = lane >> 4;
    const int nt = g.K / BK;
    unsigned voffA[2], voffB[2];
#pragma unroll
    for (int i = 0; i < 2; ++i) { int R, C; stage_rc(tid * 16 + i * 8192, R, C); const int Rb = (R & ~31) + perm32(R & 31);
        voffA[i] = (unsigned)(R * g.lda + C) * 2u; voffB[i] = (unsigned)(Rb * g.ldb + C) * 2u; }
    const size_t kstep = (size_t)(BK * 2);
    const size_t hstepA = (size_t)HALF * g.lda * 2, hstepB = (size_t)HALF * g.ldb * 2;
    const unsigned ldsw = (unsigned)wid * 1024u;
    const int aoff = lds_byte(wr * 64 + fr, fq * 8), boff = lds_byte(wc * 32 + fr, fq * 8);
#define PG8_SA(b, h) (((b) * 2 + (h)) * HTB)
#define PG8_SB(b, h) ((4 + (b) * 2 + (h)) * HTB)
#define PG8_STAGE(bufoff, gbase, voff) do { _Pragma("unroll") for (int _i = 0; _i < 2; ++_i) \
        __builtin_amdgcn_global_load_lds((const unsigned*)((const char*)(gbase) + (voff)[_i]), (LAS unsigned*)(lds + (bufoff) + ldsw + _i * 8192), 16, 0, 0); } while (0)
#define PG8_LDA(dst, b, h) do { _Pragma("unroll") for (int m = 0; m < 4; ++m) _Pragma("unroll") for (int k = 0; k < 2; ++k) dst[m][k] = *(const LAS h8*)(lds + PG8_SA(b, h) + aoff + m * 2048 + k * 1024); } while (0)
#define PG8_LDB(dst, b, h) do { _Pragma("unroll") for (int n = 0; n < 2; ++n) _Pragma("unroll") for (int k = 0; k < 2; ++k) dst[n][k] = *(const LAS h8*)(lds + PG8_SB(b, h) + boff + n * 2048 + k * 1024); } while (0)
#define PG8_MMA(ai, bj, At, Bt) do { __builtin_amdgcn_s_setprio(1); _Pragma("unroll") for (int m = 0; m < 4; ++m) _Pragma("unroll") for (int n = 0; n < 2; ++n) _Pragma("unroll") for (int k = 0; k < 2; ++k) \
        acc[ai][bj][m][n] = __builtin_amdgcn_mfma_f32_16x16x32_f16(Bt[n][k], At[m][k], acc[ai][bj][m][n], 0, 0, 0); __builtin_amdgcn_s_setprio(0); } while (0)
#define PG8_WAIT_V(n) asm volatile("s_waitcnt vmcnt(" #n ")" ::: "memory")
#define PG8_WAIT_L(n) asm volatile("s_waitcnt lgkmcnt(" #n ")" ::: "memory")
#define PG8_BAR __builtin_amdgcn_s_barrier()
#define PG8_SCHED __builtin_amdgcn_sched_barrier(0)
#define PG8_ABASE(u) ((const char*)((u).seg == 0 ? g.A[0] : (u).seg == 1 ? g.A[1] : (u).seg == 2 ? g.A[2] : g.A[3]) + (size_t)(u).pm * 2 * hstepA)
#define PG8_BBASE(u) ((const char*)((u).seg == 0 ? g.Bt[0] : (u).seg == 1 ? g.Bt[1] : (u).seg == 2 ? g.Bt[2] : g.Bt[3]) + (size_t)(u).pn * 2 * hstepB)
    Unit cur, nxt; int ui = 0;
    if (!S.next(0, cur)) return;
    f32x4 acc[2][2][4][2];
    { float z = 0.f; asm volatile("" : "+v"(z));
#pragma unroll
    for (int a = 0; a < 2; ++a)
#pragma unroll
        for (int b = 0; b < 2; ++b)
#pragma unroll
            for (int m = 0; m < 4; ++m)
#pragma unroll
                for (int n = 0; n < 2; ++n) acc[a][b][m][n] = (f32x4){z, z, z, z}; }
    h8 At[4][2], B0[2][2], B1[2][2];
    const char* cA = PG8_ABASE(cur); const char* cB = PG8_BBASE(cur);
    PG8_STAGE(PG8_SB(0, 0), cB, voffB); PG8_STAGE(PG8_SB(0, 1), cB + hstepB, voffB); PG8_STAGE(PG8_SA(0, 0), cA, voffA); PG8_STAGE(PG8_SA(0, 1), cA + hstepA, voffA);
    if (wr == 1) PG8_BAR;
    PG8_WAIT_V(2); PG8_BAR;
    PG8_STAGE(PG8_SB(1, 0), cB + kstep, voffB); PG8_STAGE(PG8_SA(1, 0), cA + kstep, voffA); PG8_STAGE(PG8_SB(1, 1), cB + hstepB + kstep, voffB);
    PG8_WAIT_V(6); PG8_BAR;
    for (;;) {
        const bool has_next = S.next(ui + 1, nxt);
        const char* nA = has_next ? PG8_ABASE(nxt) : cA; const char* nB = has_next ? PG8_BBASE(nxt) : cB;
        for (int t = 0; t < nt; t += 2) {
            const bool last = (t == nt - 2);
            const char* a1 = cA + (size_t)(t + 1) * kstep;
            const char* a2 = last ? nA : cA + (size_t)(t + 2) * kstep; const char* b2 = last ? nB : cB + (size_t)(t + 2) * kstep;
            const char* a3 = a2 + kstep; const char* b3 = b2 + kstep;
            PG8_LDB(B0, 0, 0); PG8_LDB(B1, 0, 1); PG8_SCHED; PG8_LDA(At, 0, 0); PG8_STAGE(PG8_SA(1, 1), a1 + hstepA, voffA);
            PG8_WAIT_V(8); PG8_WAIT_L(0); PG8_BAR; PG8_MMA(0, 0, At, B0); PG8_MMA(0, 1, At, B1); PG8_BAR; PG8_SCHED;
            PG8_LDA(At, 0, 1); PG8_STAGE(PG8_SB(0, 0), b2, voffB); PG8_STAGE(PG8_SB(0, 1), b2 + hstepB, voffB); PG8_STAGE(PG8_SA(0, 0), a2, voffA);
            PG8_WAIT_V(8); PG8_WAIT_L(0); PG8_BAR; PG8_MMA(1, 0, At, B0); PG8_MMA(1, 1, At, B1); PG8_BAR; PG8_SCHED;
            PG8_LDB(B0, 1, 0); PG8_LDB(B1, 1, 1); PG8_SCHED; PG8_LDA(At, 1, 0); PG8_STAGE(PG8_SA(0, 1), a2 + hstepA, voffA);
            PG8_WAIT_V(8); PG8_WAIT_L(0); PG8_BAR; PG8_MMA(0, 0, At, B0); PG8_MMA(0, 1, At, B1); PG8_BAR; PG8_SCHED;
            PG8_LDA(At, 1, 1); PG8_STAGE(PG8_SB(1, 0), b3, voffB); PG8_STAGE(PG8_SB(1, 1), b3 + hstepB, voffB); PG8_STAGE(PG8_SA(1, 0), a3, voffA);
            PG8_WAIT_V(8); PG8_WAIT_L(0); PG8_BAR; PG8_MMA(1, 0, At, B0); PG8_MMA(1, 1, At, B1); PG8_BAR; PG8_SCHED;
        }
        if (wr == 0) PG8_BAR;
        const bool keep = E(acc, cur, wr, wc, fr, fq);
        if (!has_next) break;
        if (!keep) {
            float z = 0.f; asm volatile("" : "+v"(z));
#pragma unroll
            for (int a = 0; a < 2; ++a)
#pragma unroll
                for (int b = 0; b < 2; ++b)
#pragma unroll
                    for (int m = 0; m < 4; ++m)
#pragma unroll
                        for (int n = 0; n < 2; ++n) acc[a][b][m][n] = (f32x4){z, z, z, z};
        }
        cur = nxt; cA = nA; cB = nB; ++ui;
        if (wr == 1) PG8_BAR;
    }
    PG8_WAIT_V(0);
    PG8_BAR;
#undef PG8_SA
#undef PG8_SB
#undef PG8_STAGE
#undef PG8_LDA
#undef PG8_LDB
#undef PG8_MMA
#undef PG8_WAIT_V
#undef PG8_WAIT_L
#undef PG8_BAR
#undef PG8_SCHED
#undef PG8_ABASE
#undef PG8_BBASE
}
}

__device__ __forceinline__ void xcd_order(int L, int nM, int nN, int& pm, int& pn) {
    const int nwg = nM * nN; int wgid = L;
    { const int q = nwg / 8, r = nwg % 8, xcd = wgid % 8, off = wgid / 8; wgid = (xcd < r ? xcd * (q + 1) : r * (q + 1) + (xcd - r) * q) + off; }
    const int nig = 8 * nN, gid = wgid / nig, fm = gid * 8, gsz = (nM - fm) < 8 ? (nM - fm) : 8;
    pm = fm + ((wgid % nig) % gsz); pn = (wgid % nig) / gsz;
}
struct SchedIn {
    int G, c;
    __device__ __forceinline__ bool next(int i, Unit& u) const {
        const int L = i * G + c; if (L >= 1408) return false;
        if (L < 1344) { u.seg = 0; xcd_order(L, 64, 21, u.pm, u.pn); } else { const int r = L - 1344; u.seg = 1; u.pm = r >> 3; u.pn = r & 7; }
        return true;
    }
};
struct SchedGate {
    int G, c;
    __device__ __forceinline__ bool next(int i, Unit& u) const {
        const int L = i * G + c; if (L >= 512) return false;
        u.pn = L & 1; u.seg = (L >> 1) & 3; u.pm = L >> 3; return true;
    }
};
struct SchedBr {
    int G, c;
    __device__ __forceinline__ bool next(int i, Unit& u) const {
        const int t = (i >> 1) * G + c; if (t >= 256) return false;
        u.seg = i & 1; u.pm = t >> 2; u.pn = t & 3; return true;
    }
};
struct SchedMN {
    int G, c, nN, total;
    __device__ __forceinline__ bool next(int i, Unit& u) const {
        const int L = i * G + c; if (L >= total) return false;
        u.seg = 0; xcd_order(L, total / nN, nN, u.pm, u.pn); return true;
    }
};

#define EPI_ROWS for (int ai = 0; ai < 2; ++ai) _Pragma("unroll") for (int m = 0; m < 4; ++m)
struct EpiIn {
    half_t *XR, *GG, *Q, *KB, *VT, *GR, *GA, *KC, *VCT;
    __device__ __forceinline__ bool operator()(f32x4 (&acc)[2][2][4][2], const Unit& u, int wr, int wc, int fr, int fq) const {
        const int pn = u.pn;
#pragma unroll
        EPI_ROWS {
            const int row = u.pm * 256 + ai * 128 + wr * 64 + m * 16 + fr;
#pragma unroll
            for (int bj = 0; bj < 2; ++bj) {
                const int ct = bj * 128 + wc * 32 + fq * 8;
                f32x4 a = acc[ai][bj][m][0], b = acc[ai][bj][m][1];
                if (u.seg == 0) {
                    if (pn < 4) *(h8*)(XR + (size_t)row * 1024 + pn * 256 + ct) = pack8(a, b);
                    else if (pn < 8) {
#pragma unroll
                        for (int e = 0; e < 4; ++e) { a[e] = gelu_tanh(a[e]); b[e] = gelu_tanh(b[e]); }
                        *(h8*)(GG + (size_t)row * 1024 + (pn - 4) * 256 + ct) = pack8(a, b);
                    } else if (pn < 12) *(h8*)(Q + (size_t)row * 1024 + (pn - 8) * 256 + ct) = pack8(a, b);
                    else if (pn == 12) {
                        if (bj == 0) *(h8*)(KB + (size_t)row * 128 + ct) = pack8(a, b);
                        else {
                            const int d0 = ct - 128, kvh = d0 >> 6, dd = d0 & 63, bb = row >> 11, s = row & 2047;
                            half_t* p = VT + ((size_t)((bb * 2 + kvh) * 64 + dd)) * 2048 + s;
                            const h8 v = pack8(a, b);
#pragma unroll
                            for (int e = 0; e < 8; ++e) p[(size_t)e * 2048] = v[e];
                        }
                    } else if (pn < 17) *(h8*)(GR + (size_t)row * 1024 + (pn - 13) * 256 + ct) = pack8(a, b);
                    else *(h8*)(GA + (size_t)row * 1024 + (pn - 17) * 256 + ct) = pack8(a, b);
                } else {
                    if (pn < 4) *(h8*)(KC + (size_t)row * 1024 + pn * 256 + ct) = pack8(a, b);
                    else {
                        const int hh = pn - 4, bb = row >> 8, mm = row & 255;
                        half_t* p = VCT + ((size_t)((bb * 4 + hh) * 256 + ct)) * 256 + mm;
                        const h8 v = pack8(a, b);
#pragma unroll
                        for (int e = 0; e < 8; ++e) p[(size_t)e * 256] = v[e];
                    }
                }
            }
        }
        return false;
    }
};
struct EpiGate {
    const half_t* XC; const float *brg, *big, *lam; half_t *LA, *BI;
    __device__ __forceinline__ bool operator()(f32x4 (&acc)[2][2][4][2], const Unit& u, int wr, int wc, int fr, int fq) const {
        const int ch0 = u.seg * 256 + u.pn * 128 + wc * 32 + fq * 8;
        float sp[8], b1[8], b2[8];
#pragma unroll
        for (int e = 0; e < 8; ++e) { sp[e] = softplus_neg(lam[ch0 + e]); b1[e] = brg[ch0 + e]; b2[e] = big[ch0 + e]; }
#pragma unroll
        EPI_ROWS {
            const int row = u.pm * 256 + ai * 128 + wr * 64 + m * 16 + fr;
            const h8 xc = *(const h8*)(XC + (size_t)row * 1024 + ch0);
            h8 la, bi;
#pragma unroll
            for (int e = 0; e < 8; ++e) {
                const float r = sigm(acc[ai][0][m][e >> 2][e & 3] + b1[e]), ig = sigm(acc[ai][1][m][e >> 2][e & 3] + b2[e]);
                const float l = -8.f * r * sp[e];
                const float mult = __builtin_amdgcn_sqrtf(one_minus_exp(2.f * l));
                la[e] = (half_t)l; bi[e] = (half_t)(mult * ig * (float)xc[e]);
            }
            *(h8*)(LA + (size_t)row * 1024 + ch0) = la; *(h8*)(BI + (size_t)row * 1024 + ch0) = bi;
        }
        return false;
    }
};
struct EpiBr {
    const half_t *GR, *GA; half_t* MG;
    __device__ __forceinline__ bool operator()(f32x4 (&acc)[2][2][4][2], const Unit& u, int wr, int wc, int fr, int fq) const {
#pragma unroll
        EPI_ROWS {
            const int row = u.pm * 256 + ai * 128 + wr * 64 + m * 16 + fr;
#pragma unroll
            for (int bj = 0; bj < 2; ++bj) {
                const size_t off = (size_t)row * 1024 + u.pn * 256 + bj * 128 + wc * 32 + fq * 8;
                const h8 ga = *(const h8*)(GA + off);
                if (u.seg == 0) {
                    const h8 gr = *(const h8*)(GR + off);
#pragma unroll
                    for (int e = 0; e < 8; ++e) acc[ai][bj][m][e >> 2][e & 3] *= (1.f + __expf(-(float)ga[e])) * rcpf_(1.f + __expf(-(float)gr[e]));
                } else {
                    h8 o;
#pragma unroll
                    for (int e = 0; e < 8; ++e) o[e] = (half_t)(acc[ai][bj][m][e >> 2][e & 3] * rcpf_(1.f + __expf(-(float)ga[e])));
                    *(h8*)(MG + off) = o;
                }
            }
        }
        return u.seg == 0;
    }
};
struct EpiRes {
    const float* base; float* out;
    __device__ __forceinline__ bool operator()(f32x4 (&acc)[2][2][4][2], const Unit& u, int wr, int wc, int fr, int fq) const {
#pragma unroll
        EPI_ROWS {
            const int row = u.pm * 256 + ai * 128 + wr * 64 + m * 16 + fr;
#pragma unroll
            for (int bj = 0; bj < 2; ++bj) {
                const size_t off = (size_t)row * 1024 + u.pn * 256 + bj * 128 + wc * 32 + fq * 8;
                const f32x4 x0 = *(const f32x4*)(base + off), x1 = *(const f32x4*)(base + off + 4);
                *(f32x4*)(out + off) = x0 * ALPHA + acc[ai][bj][m][0]; *(f32x4*)(out + off + 4) = x1 * ALPHA + acc[ai][bj][m][1];
            }
        }
        return false;
    }
};
struct EpiScale {
    half_t* O; float sc;
    __device__ __forceinline__ bool operator()(f32x4 (&acc)[2][2][4][2], const Unit& u, int wr, int wc, int fr, int fq) const {
#pragma unroll
        EPI_ROWS {
            const int row = u.pm * 256 + ai * 128 + wr * 64 + m * 16 + fr;
#pragma unroll
            for (int bj = 0; bj < 2; ++bj) {
                const size_t off = (size_t)row * 1024 + u.pn * 256 + bj * 128 + wc * 32 + fq * 8;
                *(h8*)(O + off) = pack8(acc[ai][bj][m][0] * sc, acc[ai][bj][m][1] * sc);
            }
        }
        return false;
    }
};
struct EpiSwiglu {
    half_t* HF;
    __device__ __forceinline__ bool operator()(f32x4 (&acc)[2][2][4][2], const Unit& u, int wr, int wc, int fr, int fq) const {
#pragma unroll
        EPI_ROWS {
            const int row = u.pm * 256 + ai * 128 + wr * 64 + m * 16 + fr;
            h8 o;
#pragma unroll
            for (int e = 0; e < 8; ++e) { const float gt = acc[ai][0][m][e >> 2][e & 3], up = acc[ai][1][m][e >> 2][e & 3]; o[e] = (half_t)(gt * sigm(gt) * up); }
            *(h8*)(HF + (size_t)row * DFF + u.pn * 128 + wc * 32 + fq * 8) = o;
        }
        return false;
    }
};

__device__ __forceinline__ int rowmap(int kind, int n0) {
    if (kind == 0) return n0;
    if (kind == 1) return (n0 >> 7) * 256 + (n0 & 127);
    if (kind == 2) return (n0 >> 7) * 256 + 128 + (n0 & 127);
    if (n0 < DFF) return (n0 >> 7) * 256 + (n0 & 127);
    const int j = n0 - DFF; return (j >> 7) * 256 + 128 + (j & 127);
}
__device__ __forceinline__ void conv_job(const float* W, int K, int N, half_t* WT, int kind, LAS float* scr, int gw, int NGW, int& base, int lane) {
    const int nblk = N / 32, nitems = (K / 64) * nblk;
    int first = gw - (base % NGW); if (first < 0) first += NGW;
    for (int item = first; item < nitems; item += NGW) {
        const int kb = item / nblk, nb = item % nblk, k0 = 64 * kb, n0 = 32 * nb;
        {
            const int kr = lane >> 3, nq = lane & 7;
            f32x4 v[8];
#pragma unroll
            for (int i = 0; i < 8; ++i) v[i] = *(const f32x4*)(W + (size_t)(k0 + kr + 8 * i) * N + n0 + 4 * nq);
#pragma unroll
            for (int i = 0; i < 8; ++i)
#pragma unroll
                for (int e = 0; e < 4; ++e) scr[(kr + 8 * i) * 33 + 4 * nq + e] = v[i][e];
        }
        asm volatile("s_waitcnt lgkmcnt(0)" ::: "memory");
        const int c = lane & 7, r0 = rowmap(kind, n0);
#pragma unroll
        for (int j = 0; j < 4; ++j) {
            const int n = (lane >> 3) + 8 * j; const LAS float* s = scr + (8 * c) * 33 + n;
            h8 o;
#pragma unroll
            for (int e = 0; e < 8; ++e) o[e] = (half_t)s[e * 33];
            *(h8*)(WT + (size_t)(r0 + n) * K + k0 + 8 * c) = o;
        }
        asm volatile("s_waitcnt lgkmcnt(0)" ::: "memory");
    }
    base += nitems;
}

typedef unsigned u32x4 __attribute__((ext_vector_type(4)));
__device__ __forceinline__ h8 hcat(h4 lo, h4 hi) { h8 v; v[0] = lo[0]; v[1] = lo[1]; v[2] = lo[2]; v[3] = lo[3]; v[4] = hi[0]; v[5] = hi[1]; v[6] = hi[2]; v[7] = hi[3]; return v; }
__device__ __forceinline__ h8 pack8s(f32x4 a, f32x4 b) { return pack8(a, b); }
__device__ __forceinline__ void swa_phase(LAS unsigned char* lds, const half_t* Q, const half_t* KB, const half_t* VT, half_t* YA, const f32x2* ROPE, const float* sinks, const int tid, const int c, const int G) {
    const int wid = __builtin_amdgcn_readfirstlane(tid >> 6), lane = tid & 63, j = lane & 15, g = lane >> 4;
    LAS half_t* Kl = (LAS half_t*)lds;
    LAS half_t* Vl = Kl + 256 * 72;
    for (int it = c; it < 256; it += G) {
        const int bb = it >> 5, nb = (it >> 1) & 15, kvh = it & 1;
#pragma unroll
        for (int r = 0; r < 2; ++r) {
            const int idx = tid + 512 * r, row = idx >> 2, cp = idx & 3, kpos = (nb - 1) * 128 + row;
            h8 c0, c1;
            { const half_t hz = (half_t)zf();
#pragma unroll
            for (int e = 0; e < 8; ++e) { c0[e] = hz; c1[e] = hz; } }
            if (kpos >= 0) {
                const half_t* kp = KB + (size_t)(bb * 2048 + kpos) * 128 + kvh * 64 + cp * 16;
                c0 = *(const h8*)kp; c1 = *(const h8*)(kp + 8);
                if (cp == 0) {
#pragma unroll
                    for (int e = 0; e < 8; ++e) { const f32x2 cs = ROPE[kpos * 8 + e]; const float t1 = (float)c0[e], t2 = (float)c1[e]; c0[e] = (half_t)(t1 * cs.x - t2 * cs.y); c1[e] = (half_t)(t2 * cs.x + t1 * cs.y); }
                }
            }
            *(LAS h8*)(Kl + row * 72 + cp * 16) = c0; *(LAS h8*)(Kl + row * 72 + cp * 16 + 8) = c1;
        }
#pragma unroll
        for (int r = 0; r < 4; ++r) {
            const int idx = tid + 512 * r, d = idx >> 5, ch = idx & 31;
            h8 v;
            { const half_t hz = (half_t)zf();
#pragma unroll
            for (int e = 0; e < 8; ++e) v[e] = hz; }
            if (nb > 0 || ch >= 16) v = *(const h8*)(VT + ((size_t)((bb * 2 + kvh) * 64 + d)) * 2048 + (nb - 1) * 128 + ch * 8);
            *(LAS h8*)(Vl + d * 264 + ch * 8) = v;
        }
        __syncthreads();
        const int kb0 = wid < 6 ? wid : 6;
        const int iq = 16 * wid + j;
        const size_t row = (size_t)bb * 2048 + nb * 128 + iq;
        f32x2 rq[8];
#pragma unroll
        for (int e = 0; e < 8; ++e) rq[e] = ROPE[(nb * 128 + iq) * 8 + e];
        const half_t* qp0 = Q + row * 1024 + kvh * 512 + 8 * g;
        h8 nq0 = *(const h8*)qp0, nq1 = *(const h8*)(qp0 + 32);
        for (int hg = 0; hg < 8; ++hg) {
            const int hh = kvh * 8 + hg;
            h8 qf0 = nq0, qf1 = nq1;
            if (hg < 7) { nq0 = *(const h8*)(qp0 + (hg + 1) * 64); nq1 = *(const h8*)(qp0 + (hg + 1) * 64 + 32); }
            {
                u32x4 self = __builtin_bit_cast(u32x4, qf0), oth;
#pragma unroll
                for (int e = 0; e < 4; ++e) oth[e] = (unsigned)shx_i((int)self[e], 16, lane);
                const h8 ot = __builtin_bit_cast(h8, oth);
                if (g < 2) {
                    const float sgn = (g == 0) ? -1.f : 1.f;
#pragma unroll
                    for (int e = 0; e < 8; ++e) qf0[e] = (half_t)((float)qf0[e] * rq[e].x + sgn * (float)ot[e] * rq[e].y);
                }
            }
#pragma unroll
            for (int e = 0; e < 8; ++e) { qf0[e] = qf0[e] * (half_t)0.125f; qf1[e] = qf1[e] * (half_t)0.125f; }
            f32x4 sc[10];
#pragma unroll
            for (int kb = 0; kb < 10; ++kb) {
                const LAS half_t* kp = Kl + (16 * (kb0 + kb) + j) * 72 + 8 * g;
                const float z_ = zf(); f32x4 a = (f32x4){z_, z_, z_, z_};
                a = __builtin_amdgcn_mfma_f32_16x16x32_f16(*(const LAS h8*)kp, qf0, a, 0, 0, 0);
                a = __builtin_amdgcn_mfma_f32_16x16x32_f16(*(const LAS h8*)(kp + 32), qf1, a, 0, 0, 0);
                sc[kb] = a;
            }
            const float sk = sinks[hh];
            float mx = sk;
#pragma unroll
            for (int kb = 0; kb < 10; ++kb)
#pragma unroll
                for (int r = 0; r < 4; ++r) {
                    const int jk = 16 * (kb0 + kb) + 4 * g + r;
                    const bool valid = (jk > iq) && (jk <= iq + 128) && (nb > 0 || jk >= 128);
                    sc[kb][r] = valid ? sc[kb][r] : -1e30f; mx = fmaxf(mx, sc[kb][r]);
                }
            mx = fmaxf(mx, shx(mx, 16, lane)); mx = fmaxf(mx, shx(mx, 32, lane));
            float sum = 0.f;
#pragma unroll
            for (int kb = 0; kb < 10; ++kb)
#pragma unroll
                for (int r = 0; r < 4; ++r) { const float pv = __expf(sc[kb][r] - mx); sc[kb][r] = pv; sum += pv; }
            sum += shx(sum, 16, lane); sum += shx(sum, 32, lane); sum += __expf(sk - mx);
            f32x4 o[4];
#pragma unroll
            for (int db = 0; db < 4; ++db) { const float z_ = zf(); o[db] = (f32x4){z_, z_, z_, z_}; }
#pragma unroll
            for (int pp = 0; pp < 5; ++pp) {
                const h8 pb = pack8(sc[2 * pp], sc[2 * pp + 1]);
#pragma unroll
                for (int db = 0; db < 4; ++db) {
                    const LAS half_t* vp = Vl + (16 * db + j) * 264 + 16 * (kb0 + 2 * pp) + 4 * g;
                    const h8 av = hcat(*(const LAS h4*)vp, *(const LAS h4*)(vp + 16));
                    o[db] = __builtin_amdgcn_mfma_f32_16x16x32_f16(av, pb, o[db], 0, 0, 0);
                }
            }
            const float inv = rcpf_(sum);
#pragma unroll
            for (int db = 0; db < 4; ++db) {
                h4 oh; oh[0] = (half_t)(o[db][0] * inv); oh[1] = (half_t)(o[db][1] * inv); oh[2] = (half_t)(o[db][2] * inv); oh[3] = (half_t)(o[db][3] * inv);
                *(h4*)(YA + row * 1024 + hh * 64 + 16 * db + 4 * g) = oh;
            }
        }
        __syncthreads();
    }
}
__device__ __forceinline__ void cross_phase(LAS unsigned char* lds, const half_t* QC, const half_t* KC, const half_t* VCT, half_t* OC, const int tid, const int c, const int G) {
    const int wid = __builtin_amdgcn_readfirstlane(tid >> 6), lane = tid & 63, j = lane & 15, g = lane >> 4;
    LAS half_t* Kl = (LAS half_t*)lds;
    for (int it = c; it < 512; it += G) {
        const int bb = it >> 6, hh = (it >> 4) & 3, qb = it & 15;
#pragma unroll
        for (int r = 0; r < 16; ++r) {
            const int idx = tid + 512 * r, m = idx >> 5, ch = idx & 31;
            *(LAS h8*)(Kl + m * 264 + ch * 8) = *(const h8*)(KC + (size_t)(bb * 256 + m) * 1024 + hh * 256 + ch * 8);
        }
        const size_t row = (size_t)bb * 2048 + qb * 128 + 16 * wid + j;
        h8 qf[8];
#pragma unroll
        for (int ks = 0; ks < 8; ++ks) qf[ks] = *(const h8*)(QC + row * 1024 + hh * 256 + 32 * ks + 8 * g);
        __syncthreads();
        f32x4 sc[16];
#pragma unroll
        for (int kb = 0; kb < 16; ++kb) {
            const LAS half_t* kp = Kl + (16 * kb + j) * 264 + 8 * g;
            const float z_ = zf(); f32x4 a = (f32x4){z_, z_, z_, z_};
#pragma unroll
            for (int ks = 0; ks < 8; ++ks) a = __builtin_amdgcn_mfma_f32_16x16x32_f16(*(const LAS h8*)(kp + 32 * ks), qf[ks], a, 0, 0, 0);
            sc[kb] = a;
        }
        float mx = -1e30f;
#pragma unroll
        for (int kb = 0; kb < 16; ++kb)
#pragma unroll
            for (int r = 0; r < 4; ++r) mx = fmaxf(mx, sc[kb][r]);
        mx = fmaxf(mx, shx(mx, 16, lane)); mx = fmaxf(mx, shx(mx, 32, lane));
        float sum = 0.f;
#pragma unroll
        for (int kb = 0; kb < 16; ++kb)
#pragma unroll
            for (int r = 0; r < 4; ++r) { const float pv = __expf(sc[kb][r] - mx); sc[kb][r] = pv; sum += pv; }
        sum += shx(sum, 16, lane); sum += shx(sum, 32, lane);
        h8 pb[8];
#pragma unroll
        for (int pp = 0; pp < 8; ++pp) pb[pp] = pack8(sc[2 * pp], sc[2 * pp + 1]);
        __syncthreads();
#pragma unroll
        for (int r = 0; r < 16; ++r) {
            const int idx = tid + 512 * r, d = idx >> 5, ch = idx & 31;
            *(LAS h8*)(Kl + d * 264 + ch * 8) = *(const h8*)(VCT + ((size_t)((bb * 4 + hh) * 256 + d)) * 256 + ch * 8);
        }
        __syncthreads();
        const float inv = 1.f / sum;
#pragma unroll
        for (int db = 0; db < 16; ++db) {
            const float z_ = zf(); f32x4 o = (f32x4){z_, z_, z_, z_};
#pragma unroll
            for (int pp = 0; pp < 8; ++pp) {
                const LAS half_t* vp = Kl + (16 * db + j) * 264 + 32 * pp + 4 * g;
                o = __builtin_amdgcn_mfma_f32_16x16x32_f16(hcat(*(const LAS h4*)vp, *(const LAS h4*)(vp + 16)), pb[pp], o, 0, 0, 0);
            }
            h4 oh; oh[0] = (half_t)(o[0] * inv); oh[1] = (half_t)(o[1] * inv); oh[2] = (half_t)(o[2] * inv); oh[3] = (half_t)(o[3] * inv);
            *(h4*)(OC + row * 1024 + hh * 256 + 16 * db + 4 * g) = oh;
        }
        __syncthreads();
    }
}

#define XB_TMO      128
#define XB_XCNT(j)  (256  + 64 * (j))
#define XB_XSUB(j)  (1280 + 64 * (j))
#define XB_XGEN(j)  (2304 + 64 * (j))
#define XB_TOP      3328
#define XB_TOPGEN   3392
#define XCD_BAR_WORDS 3456
#define XB_SPIN_CAP (1u << 18)
__device__ __forceinline__ unsigned xb_ld(unsigned* p)              { return __hip_atomic_load(p, __ATOMIC_RELAXED, __HIP_MEMORY_SCOPE_AGENT); }
__device__ __forceinline__ unsigned xb_add(unsigned* p, unsigned v) { return __hip_atomic_fetch_add(p, v, __ATOMIC_RELAXED, __HIP_MEMORY_SCOPE_AGENT); }
__device__ __forceinline__ unsigned xb_xcc_id() { return (unsigned)__builtin_amdgcn_s_getreg((3 << 11) | 20) & 0xFu; }
#define XB_SPIN(cond, bar) do { unsigned _sp = 0; while (cond) { __builtin_amdgcn_s_sleep(1); \
    if ((++_sp & 255u) == 0u) { if (xb_ld(&(bar)[XB_TMO])) break; if (_sp > XB_SPIN_CAP) { atomicAdd(&(bar)[XB_TMO], 1u); break; } } } } while (0)
struct XcdBarrier { unsigned* bar; unsigned x; volatile LAS unsigned* st; };
__device__ __forceinline__ XcdBarrier xcd_barrier_post(unsigned* bar, volatile LAS unsigned* st) {
    XcdBarrier b; b.bar = bar; b.x = xb_xcc_id(); b.st = st;
    if (threadIdx.x == 0) (void)xb_add(&bar[XB_XCNT(b.x)], 1u);
    return b;
}
__device__ __forceinline__ void xcd_barrier_complete(unsigned* bar, unsigned x, unsigned& nloc, unsigned& nx) {
    const unsigned G = gridDim.x * gridDim.y * gridDim.z;
    unsigned sum, cnt, mine, sp = 0u;
    for (;;) {
        sum = 0u; cnt = 0u; mine = 0u;
#pragma unroll
        for (unsigned j = 0; j < 16; ++j) { const unsigned c = xb_ld(&bar[XB_XCNT(j)]); sum += c; cnt += (c > 0u) ? 1u : 0u; mine = (j == x) ? c : mine; }
        if (sum == G) break;
        __builtin_amdgcn_s_sleep(1);
        if ((++sp & 255u) == 0u) { if (xb_ld(&bar[XB_TMO])) break; if (sp > XB_SPIN_CAP) { atomicAdd(&bar[XB_TMO], 1u); break; } }
    }
    nloc = mine > 0u ? mine : 1u; nx = cnt > 0u ? cnt : 1u;
}
__device__ __forceinline__ void xcd_barrier(const XcdBarrier& b) {
    asm volatile("s_waitcnt vmcnt(0)" ::: "memory");
    __syncthreads();
    if (threadIdx.x == 0) {
        unsigned* bar = b.bar;
        __builtin_amdgcn_s_waitcnt(0);
        unsigned nloc = b.st[0], nx = b.st[1];
        if (nloc == 0u) { xcd_barrier_complete(bar, b.x, nloc, nx); b.st[0] = nloc; b.st[1] = nx; }
        const unsigned old = xb_add(&bar[XB_XSUB(b.x)], 1u);
        const unsigned gen = old / nloc;
        if (old + 1u == (gen + 1u) * nloc) {
            __builtin_amdgcn_fence(__ATOMIC_RELEASE, "agent");
            asm volatile("s_waitcnt vmcnt(0)" ::: "memory");
            const unsigned og = xb_add(&bar[XB_TOP], 1u);
            const unsigned tg = og / nx;
            if (og + 1u == (tg + 1u) * nx) xb_add(&bar[XB_TOPGEN], 1u);
            else XB_SPIN(xb_ld(&bar[XB_TOPGEN]) == tg, bar);
            __builtin_amdgcn_fence(__ATOMIC_ACQUIRE, "agent");
            xb_add(&bar[XB_XGEN(b.x)], 1u);
            asm volatile("s_waitcnt vmcnt(0)" ::: "memory");
        } else {
            XB_SPIN(xb_ld(&bar[XB_XGEN(b.x)]) == gen, bar);
            __builtin_amdgcn_fence(__ATOMIC_ACQUIRE, "agent");
            asm volatile("s_waitcnt vmcnt(0)" ::: "memory");
        }
    }
    __syncthreads();
}

constexpr int NPH = 15;
__constant__ double INVF[8] = {1.0, 0.19392274474868576, 0.03760603093086393, 0.007292664737217109, 0.001414213562373095, 0.0002742481756762073, 5.318295896944988e-05, 1.031338537721246e-05};
__device__ __forceinline__ void sincos_d(double ang, float& c, float& s) {
    const double n = __builtin_rint(ang * 0.6366197723675814);
    double r = __builtin_fma(-n, 1.5707963267948966, ang); r = __builtin_fma(-n, 6.123233995736766e-17, r);
    const double r2 = r * r;
    double sp = r * (1.0 + r2 * (-1.0 / 6 + r2 * (1.0 / 120 + r2 * (-1.0 / 5040 + r2 * (1.0 / 362880 + r2 * (-1.0 / 39916800 + r2 * (1.0 / 6227020800.0)))))));
    double cp = 1.0 + r2 * (-0.5 + r2 * (1.0 / 24 + r2 * (-1.0 / 720 + r2 * (1.0 / 40320 + r2 * (-1.0 / 3628800 + r2 * (1.0 / 479001600 + r2 * (-1.0 / 87178291200.0)))))));
    const int q = ((int)n) & 3;
    const double cc = (q == 0) ? cp : (q == 1) ? -sp : (q == 2) ? -cp : sp;
    const double ss = (q == 0) ? sp : (q == 1) ? cp : (q == 2) ? -sp : -cp;
    c = (float)cc; s = (float)ss;
}

typedef const __attribute__((address_space(4))) Args* ArgsP;
__device__ __forceinline__ void run_phase(ArgsP args, const int ph, unsigned char* ws, const int tid, LAS unsigned char* lds, const int G, const int c) {
    const int lane = tid & 63, wid = __builtin_amdgcn_readfirstlane(tid >> 6);
    const int gw = c * NWAVES + wid, NGW = G * NWAVES;
    f32x2* ROPE = (f32x2*)(ws + WS_ROPE);
    half_t *W_in = (half_t*)(ws + WS_W + W_IN), *W_g = (half_t*)(ws + WS_W + W_G), *W_br = (half_t*)(ws + WS_W + W_BR), *W_ba = (half_t*)(ws + WS_W + W_BA),
           *W_out = (half_t*)(ws + WS_W + W_OUT), *W_cq = (half_t*)(ws + WS_W + W_CQ), *W_co = (half_t*)(ws + WS_W + W_CO), *W_ckv = (half_t*)(ws + WS_W + W_CKV),
           *W_fi = (half_t*)(ws + WS_W + W_FI), *W_fo = (half_t*)(ws + WS_W + W_FO);
    half_t *MEM16 = (half_t*)(ws + WS_MEM16), *KB = (half_t*)(ws + WS_KB), *VT = (half_t*)(ws + WS_VT), *KC = (half_t*)(ws + WS_KC), *VCT = (half_t*)(ws + WS_VCT);
#define SLOTP(i) ((half_t*)(ws + WS_SLOT + (size_t)(i) * SLOT))
    half_t *H16 = SLOTP(0), *XR = SLOTP(1), *LA = SLOTP(1), *MG = SLOTP(1), *GG = SLOTP(2), *QC = SLOTP(2), *Q = SLOTP(3), *BI = SLOTP(3), *OC = SLOTP(3),
           *GR = SLOTP(4), *GA = SLOTP(5), *XC = SLOTP(6), *YR = SLOTP(6), *YA = SLOTP(7), *HF = SLOTP(4);
    float* OUT = args->out;
    {
        const int l = ph / NPH, k = ph % NPH;
        if (k == 0) {
            LAS float* scr = (LAS float*)(lds + wid * 16384);
            int base = 0;
            conv_job(args->in[I_WIN] + (size_t)l * DM * INC, DM, INC, W_in, 0, scr, gw, NGW, base, lane);
            conv_job(args->in[I_FWI] + (size_t)l * DM * 2 * DFF, DM, 2 * DFF, W_fi, 3, scr, gw, NGW, base, lane);
            conv_job(args->in[I_FWO] + (size_t)l * DFF * DM, DFF, DM, W_fo, 0, scr, gw, NGW, base, lane);
            conv_job(args->in[I_CKV] + (size_t)l * DM * 2048, DM, 2048, W_ckv, 0, scr, gw, NGW, base, lane);
            conv_job(args->in[I_WBR] + (size_t)l * DM * DM, DM, DM, W_br, 0, scr, gw, NGW, base, lane);
            conv_job(args->in[I_WBA] + (size_t)l * DM * DM, DM, DM, W_ba, 0, scr, gw, NGW, base, lane);
            conv_job(args->in[I_WOUT] + (size_t)l * DM * DM, DM, DM, W_out, 0, scr, gw, NGW, base, lane);
            conv_job(args->in[I_CQ] + (size_t)l * DM * DM, DM, DM, W_cq, 0, scr, gw, NGW, base, lane);
            conv_job(args->in[I_CO] + (size_t)l * DM * DM, DM, DM, W_co, 0, scr, gw, NGW, base, lane);
            for (int n = 0; n < 4; ++n) {
                conv_job(args->in[I_WRG] + (size_t)(l * 4 + n) * 65536, 256, 256, W_g + (size_t)n * 512 * 256, 1, scr, gw, NGW, base, lane);
                conv_job(args->in[I_WIG] + (size_t)(l * 4 + n) * 65536, 256, 256, W_g + (size_t)n * 512 * 256, 2, scr, gw, NGW, base, lane);
            }
            if (l == 0) {
                const int gt = c * NTHREADS + tid, NGT = G * NTHREADS;
                const float* x = args->in[I_X]; const float* mem = args->in[I_MEM];
                for (int i = gt; i < M * DM / 8; i += NGT) { const f32x4 a = *(const f32x4*)(x + (size_t)i * 8), b = *(const f32x4*)(x + (size_t)i * 8 + 4); *(h8*)(H16 + (size_t)i * 8) = pack8(a, b); }
                for (int i = gt; i < MMEM * DM / 8; i += NGT) { const f32x4 a = *(const f32x4*)(mem + (size_t)i * 8), b = *(const f32x4*)(mem + (size_t)i * 8 + 4); *(h8*)(MEM16 + (size_t)i * 8) = pack8(a, b); }
            }
        } else if (k == 1) {
            Gemm g; g.K = DM; g.lda = DM; g.ldb = DM; g.A[0] = H16; g.Bt[0] = W_in; g.A[1] = MEM16; g.Bt[1] = W_ckv; g.A[2] = H16; g.Bt[2] = W_in; g.A[3] = H16; g.Bt[3] = W_in;
            SchedIn S{G, c}; EpiIn E{XR, GG, Q, KB, VT, GR, GA, KC, VCT};
            pg8::gemm_phase(lds, g, S, E, tid);
        } else if (k == 2) {
            {
                const float* cw = args->in[I_CONVW] + (size_t)l * 4 * DM; const float* cb = args->in[I_CONVB] + (size_t)l * DM;
                const int gt = c * NTHREADS + tid, NGT = G * NTHREADS;
                for (int i = gt; i < M * 128; i += NGT) {
                    const int row = i >> 7, ch = (i & 127) * 8, s = row & 2047;
                    float a[8];
#pragma unroll
                    for (int e = 0; e < 8; ++e) a[e] = cb[ch + e];
#pragma unroll
                    for (int kk = 0; kk < 4; ++kk) {
                        if (s - 3 + kk >= 0) {
                            const h8 v = *(const h8*)(XR + (size_t)(row - 3 + kk) * 1024 + ch);
#pragma unroll
                            for (int e = 0; e < 8; ++e) a[e] += (float)v[e] * cw[kk * DM + ch + e];
                        }
                    }
                    h8 o;
#pragma unroll
                    for (int e = 0; e < 8; ++e) o[e] = (half_t)a[e];
                    *(h8*)(XC + (size_t)row * 1024 + ch) = o;
                }
            }
            swa_phase(lds, Q, KB, VT, YA, ROPE, args->in[I_SINK] + l * 16, tid, c, G);
        } else if (k == 3) {
            Gemm g; g.K = 256; g.lda = DM; g.ldb = 256;
#pragma unroll
            for (int n = 0; n < 4; ++n) { g.A[n] = XC + n * 256; g.Bt[n] = W_g + (size_t)n * 512 * 256; }
            SchedGate S{G, c};
            EpiGate E{XC, args->in[I_BRG] + l * DM, args->in[I_BIG] + l * DM, args->in[I_LAM] + l * DM, LA, BI};
            pg8::gemm_phase(lds, g, S, E, tid);
        } else if (k == 4) {
            LAS float* sA = (LAS float*)lds; LAS float* sH = sA + 128 * 32;
            for (int it = c; it < BATCH * 32; it += G) {
                const int bb = it >> 5, grp = tid & 3, chunk = tid >> 2, ch = (it & 31) * 32 + grp * 8;
                const size_t o0 = ((size_t)bb * SEQ + chunk * 16) * 1024 + ch;
                h8 la[16], bi[16];
#pragma unroll
                for (int t = 0; t < 16; ++t) { la[t] = *(const h8*)(LA + o0 + (size_t)t * 1024); bi[t] = *(const h8*)(BI + o0 + (size_t)t * 1024); }
                float Ap[8], Hh[8];
#pragma unroll
                for (int e = 0; e < 8; ++e) { Ap[e] = 1.f; Hh[e] = 0.f; }
#pragma unroll
                for (int t = 0; t < 16; ++t)
#pragma unroll
                    for (int e = 0; e < 8; ++e) { const float a = __expf((float)la[t][e]); Hh[e] = a * Hh[e] + (float)bi[t][e]; Ap[e] *= a; }
                __syncthreads();
#pragma unroll
                for (int e = 0; e < 8; ++e) { sA[chunk * 32 + grp * 8 + e] = Ap[e]; sH[chunk * 32 + grp * 8 + e] = Hh[e]; }
                __syncthreads();
                float h[8];
#pragma unroll
                for (int e = 0; e < 8; ++e) h[e] = 0.f;
#pragma unroll
                for (int t = 0; t < 16; ++t) asm volatile("" : "+v"(la[t]));
                for (int j = 0; j < chunk; ++j) {
                    const f32x4 a0 = *(const LAS f32x4*)(sA + j * 32 + grp * 8), a1 = *(const LAS f32x4*)(sA + j * 32 + grp * 8 + 4);
                    const f32x4 h0 = *(const LAS f32x4*)(sH + j * 32 + grp * 8), h1 = *(const LAS f32x4*)(sH + j * 32 + grp * 8 + 4);
#pragma unroll
                    for (int e = 0; e < 4; ++e) { h[e] = a0[e] * h[e] + h0[e]; h[4 + e] = a1[e] * h[4 + e] + h1[e]; }
                }
#pragma unroll
                for (int qt = 0; qt < 4; ++qt) {
                    h8 gg[4], b2[4];
#pragma unroll
                    for (int t = 0; t < 4; ++t) { gg[t] = *(const h8*)(GG + o0 + (size_t)(qt * 4 + t) * 1024); b2[t] = *(const volatile h8*)(BI + o0 + (size_t)(qt * 4 + t) * 1024); }
#pragma unroll
                    for (int t = 0; t < 4; ++t) {
                        h8 y;
#pragma unroll
                        for (int e = 0; e < 8; ++e) { const float a = __expf((float)la[qt * 4 + t][e]); h[e] = a * h[e] + (float)b2[t][e]; y[e] = (half_t)(h[e] * (float)gg[t][e]); }
                        *(h8*)(YR + o0 + (size_t)(qt * 4 + t) * 1024) = y;
                    }
                }
            }
        } else if (k == 5) {
            Gemm g; g.K = DM; g.lda = DM; g.ldb = DM; g.A[0] = YR; g.Bt[0] = W_br; g.A[1] = YA; g.Bt[1] = W_ba; g.A[2] = YR; g.Bt[2] = W_br; g.A[3] = YR; g.Bt[3] = W_br;
            SchedBr S{G, c}; EpiBr E{GR, GA, MG};
            pg8::gemm_phase(lds, g, S, E, tid);
        } else if (k == 6 || k == 10 || k == 13) {
            Gemm g; g.K = (k == 13) ? DFF : DM;
            const half_t* A = (k == 6) ? MG : (k == 10) ? OC : HF; const half_t* B = (k == 6) ? W_out : (k == 10) ? W_co : W_fo;
            g.lda = g.K; g.ldb = g.K;
#pragma unroll
            for (int n = 0; n < 4; ++n) { g.A[n] = A; g.Bt[n] = B; }
            SchedMN S{G, c, 4, 256};
            EpiRes E{(l == 0 && k == 6) ? args->in[I_X] : OUT, OUT};
            pg8::gemm_phase(lds, g, S, E, tid);
        } else if (k == 7 || k == 11 || k == 14) {
            const int gi = (k == 7) ? I_LN1G : (k == 11) ? I_LN2G : I_LN3G;
            const float* gam = args->in[gi] + l * DM; const float* bet = args->in[gi + 1] + l * DM;
            for (int row = gw; row < M; row += NGW) {
                f32x4* xr = (f32x4*)(OUT + (size_t)row * DM) + lane;
                f32x4 v[4]; float s = 0.f;
#pragma unroll
                for (int j = 0; j < 4; ++j) { v[j] = xr[64 * j]; s += (v[j][0] + v[j][1]) + (v[j][2] + v[j][3]); }
                const float mean = wave_sum(s, lane) * (1.f / DM); float s2 = 0.f;
#pragma unroll
                for (int j = 0; j < 4; ++j) { v[j] = v[j] - mean; s2 += (v[j][0] * v[j][0] + v[j][1] * v[j][1]) + (v[j][2] * v[j][2] + v[j][3] * v[j][3]); }
                const float rstd = 1.f / sqrtf(wave_sum(s2, lane) * (1.f / DM) + LN_EPS);
#pragma unroll
                for (int j = 0; j < 4; ++j) {
                    const f32x4 gg = *((const f32x4*)gam + lane + 64 * j), be = *((const f32x4*)bet + lane + 64 * j);
                    const f32x4 o = v[j] * rstd * gg + be;
                    xr[64 * j] = o;
                    h4 oh; oh[0] = (half_t)o[0]; oh[1] = (half_t)o[1]; oh[2] = (half_t)o[2]; oh[3] = (half_t)o[3];
                    *((h4*)(H16 + (size_t)row * DM) + lane + 64 * j) = oh;
                }
            }
        } else if (k == 8) {
            Gemm g; g.K = DM; g.lda = DM; g.ldb = DM;
#pragma unroll
            for (int n = 0; n < 4; ++n) { g.A[n] = H16; g.Bt[n] = W_cq; }
            SchedMN S{G, c, 4, 256}; EpiScale E{QC, 0.0625f};
            pg8::gemm_phase(lds, g, S, E, tid);
        } else if (k == 9) {
            cross_phase(lds, QC, KC, VCT, OC, tid, c, G);
        } else if (k == 12) {
            Gemm g; g.K = DM; g.lda = DM; g.ldb = DM;
#pragma unroll
            for (int n = 0; n < 4; ++n) { g.A[n] = H16; g.Bt[n] = W_fi; }
            SchedMN S{G, c, 22, 64 * 22}; EpiSwiglu E{HF};
            pg8::gemm_phase(lds, g, S, E, tid);
        }
    }
}

__global__ void __launch_bounds__(NTHREADS) fwd_kernel(Args args_unused) {
    extern __shared__ __attribute__((aligned(16))) unsigned char lds_raw[];
    cg::grid_group grid = cg::this_grid();
    ArgsP ap0 = (ArgsP)__builtin_amdgcn_kernarg_segment_ptr();
    const int ph_lo = ap0->ph_lo, ph_hi = ap0->ph_hi;
    volatile LAS unsigned* bst = (volatile LAS unsigned*)((LAS unsigned char*)lds_raw + LDS_BYTES - 64);
    if (threadIdx.x == 0) { bst[0] = 0u; bst[1] = 0u; }
    __syncthreads();
    const XcdBarrier xbar = xcd_barrier_post((unsigned*)ap0->ws, bst);
    if (ph_lo == 0) {
        f32x2* ROPE = (f32x2*)(ap0->ws + WS_ROPE);
        for (int i = blockIdx.x * NTHREADS + threadIdx.x; i < SEQ * 8; i += gridDim.x * NTHREADS) {
            float cs, sn; sincos_d((double)(i >> 3) * INVF[i & 7], cs, sn);
            ROPE[i] = (f32x2){cs, sn};
        }
    }
    for (int ph = ph_lo; ph < ph_hi; ++ph) {
        ArgsP ap = (ArgsP)__builtin_amdgcn_kernarg_segment_ptr();
        asm volatile("" : "+s"(ap));
        unsigned char* ws = ap->ws; int tid = threadIdx.x;
        int Gx = gridDim.x, cx = blockIdx.x;
        asm volatile("" : "+s"(ws)); asm volatile("" : "+v"(tid)); asm volatile("" : "+s"(Gx)); asm volatile("" : "+s"(cx));
        run_phase(ap, ph, ws, tid, (LAS unsigned char*)lds_raw, Gx, cx);
#ifdef XREP
        { const int kx = ph % NPH; if ((XREP >> kx) & 1) { xcd_barrier(xbar); asm volatile("" : "+s"(ws)); asm volatile("" : "+v"(tid)); run_phase(ap, ph, ws, tid, (LAS unsigned char*)lds_raw, Gx, cx); } }
#endif
#ifdef XSYNC
        xcd_barrier(xbar);
#endif
        if (ph + 1 < ph_hi) { if (ph == ph_lo) grid.sync(); else xcd_barrier(xbar); }
    }
}

extern "C" void kernel_launch(void* const* d_in, const int* in_sizes, int n_in, void* d_out, int out_size, void* d_ws, size_t ws_size, hipStream_t stream) {
    static int grid = 0;
    if (grid == 0) {
        if (n_in != 25 || ws_size < WS_END) { fprintf(stderr, "kernel_launch: unexpected n_in %d / ws_size %zu (need %zu)\n", n_in, ws_size, (size_t)WS_END); grid = -1; return; }
        int dev = 0, cus = 0, per_cu = 0;
        hipGetDevice(&dev); hipDeviceGetAttribute(&cus, hipDeviceAttributeMultiprocessorCount, dev);
        hipFuncSetAttribute((const void*)fwd_kernel, hipFuncAttributeMaxDynamicSharedMemorySize, LDS_BYTES);
        hipOccupancyMaxActiveBlocksPerMultiprocessor(&per_cu, (const void*)fwd_kernel, NTHREADS, LDS_BYTES);
        if (per_cu < 1) per_cu = 1;
        grid = cus * per_cu;
        (void)hipGetLastError();
    }
    if (grid < 0) return;
    hipMemsetAsync(d_ws, 0, 16384, stream);
    Args a{};
    for (int i = 0; i < 25; ++i) a.in[i] = (const float*)d_in[i];
    a.out = (float*)d_out; a.ws = (unsigned char*)d_ws;
    a.ph_lo = 0; a.ph_hi = DEPTH * NPH;
    void* kargs[] = {&a};
    hipError_t e = hipLaunchCooperativeKernel((const void*)fwd_kernel, dim3(grid), dim3(NTHREADS), kargs, LDS_BYTES, stream);
    if (e != hipSuccess) fprintf(stderr, "cooperative launch failed: %s (grid %d)\n", hipGetErrorString(e), grid);
}
```
